# Optimizing an MI355X kernel written in HIP

```python
import math
import jax, jax.numpy as jnp
from jax import lax
import numpy as np

D_MODEL = 1024
BATCH = 8
SEQ = 2048
DEPTH = 4

N_MIXERS = 2
N_MEM = 256
XA_HEADS = 4
XA_WIDTH = D_MODEL // 4
XA_HEAD_DIM = XA_WIDTH // XA_HEADS
MIX_WIDTH = D_MODEL - XA_WIDTH
GLA_HEADS = 4
GLA_DV = MIX_WIDTH
GLA_DK = MIX_WIDTH // 2
GLA_HEAD_K = GLA_DK // GLA_HEADS
GLA_HEAD_V = GLA_DV // GLA_HEADS
GLA_GATE_RANK = 16
GLA_GATE_TAU = 16.0
GLA_CHUNK = 64
CONV_GROUPS = 4
CONV_WIDTH = 3
D_FF = int(math.ceil(8 * D_MODEL / 3 / 128)) * 128
FFN_CONV_WIDTH = 3
LN_EPS = 1e-5
DEEPNORM_ALPHA = (2 * DEPTH) ** 0.25
DEEPNORM_BETA = (8 * DEPTH) ** -0.25
N_GLA_LAYERS = (DEPTH + 1) // 2
N_CONV_LAYERS = DEPTH // 2
GLA_IN_SIZES = (GLA_DK, GLA_DK, GLA_DV, GLA_DV, GLA_GATE_RANK, XA_WIDTH)
CONV_IN_SIZES = (MIX_WIDTH, MIX_WIDTH, MIX_WIDTH, XA_WIDTH)
GLA_IN = sum(GLA_IN_SIZES)
CONV_IN = sum(CONV_IN_SIZES)

kernel_name = "hybrid_gla_shortconv_memxattn"


def split_cols(t, sizes):
    idx = np.cumsum(np.array(sizes))[:-1].tolist()
    return jnp.split(t, idx, axis=-1)


def layer_norm(x, g, b):
    xf = x.astype(jnp.float32)
    mu = jnp.mean(xf, axis=-1, keepdims=True)
    var = jnp.mean(jnp.square(xf - mu), axis=-1, keepdims=True)
    return ((xf - mu) * lax.rsqrt(var + LN_EPS)).astype(x.dtype) * g + b


def causal_dwconv(x, w):
    K = w.shape[0]
    S = x.shape[1]
    xp = jnp.pad(x, ((0, 0), (K - 1, 0), (0, 0)))
    y = xp[:, 0:S, :] * w[0]
    for kk in range(1, K):
        y = y + xp[:, kk:kk + S, :] * w[kk]
    return y


def gla_mixer(q, k, v, r, gate_lr, w_a2, b_a, head_g):
    bsz, seq, _ = q.shape
    n_chunks = seq // GLA_CHUNK
    f32 = jnp.float32

    def to_chunks(t, dh):
        return t.reshape(bsz, n_chunks, GLA_CHUNK, GLA_HEADS, dh).transpose(0, 3, 1, 2, 4)

    log_a = jax.nn.log_sigmoid((gate_lr @ w_a2 + b_a).astype(f32)) / GLA_GATE_TAU
    G = jnp.cumsum(to_chunks(log_a, GLA_HEAD_K), axis=3)
    G_last = G[:, :, :, -1:, :]
    qc = to_chunks(q, GLA_HEAD_K).astype(f32) * (GLA_HEAD_K ** -0.5)
    kc = to_chunks(k, GLA_HEAD_K).astype(f32)
    vc = to_chunks(v, GLA_HEAD_V).astype(f32)

    q_dec = qc * jnp.exp(G)
    k_inv = kc * jnp.exp(-G)
    k_end = kc * jnp.exp(G_last - G)

    causal = jnp.tril(jnp.ones((GLA_CHUNK, GLA_CHUNK), dtype=bool))
    att = jnp.einsum('bhnik,bhnjk->bhnij', q_dec, k_inv)
    att = jnp.where(causal, att, 0.0)
    o_intra = jnp.einsum('bhnij,bhnjv->bhniv', att, vc)

    kv_chunk = jnp.einsum('bhnck,bhncv->bhnkv', k_end, vc)
    decay_chunk = jnp.exp(G_last[:, :, :, 0, :])

    def step(state, inp):
        kv_n, d_n = inp
        return d_n[..., None] * state + kv_n, state

    init = jnp.zeros((bsz, GLA_HEADS, GLA_HEAD_K, GLA_HEAD_V), f32)
    _, states = lax.scan(step, init, (jnp.moveaxis(kv_chunk, 2, 0), jnp.moveaxis(decay_chunk, 2, 0)))
    states = jnp.moveaxis(states, 0, 2)
    o_inter = jnp.einsum('bhnck,bhnkv->bhncv', q_dec, states)

    o = o_intra + o_inter
    o = o * lax.rsqrt(jnp.mean(jnp.square(o), axis=-1, keepdims=True) + LN_EPS)
    o = o.transpose(0, 2, 3, 1, 4).reshape(bsz, seq, GLA_DV).astype(v.dtype) * head_g
    return o * jax.nn.silu(r)


def short_conv_mixer(b_gate, c_gate, h, conv_w):
    return b_gate * causal_dwconv(c_gate * h, conv_w)


def memory_xattn(q, mem_kv):
    bsz, seq, _ = q.shape
    m = mem_kv.shape[1]
    k, v = jnp.split(mem_kv, 2, axis=-1)
    qh = q.reshape(bsz, seq, XA_HEADS, XA_HEAD_DIM)
    kh = k.reshape(bsz, m, XA_HEADS, XA_HEAD_DIM)
    vh = v.reshape(bsz, m, XA_HEADS, XA_HEAD_DIM)
    s = jnp.einsum('bshd,bmhd->bhsm', qh, kh).astype(jnp.float32) * (XA_HEAD_DIM ** -0.5)
    p = jax.nn.softmax(s, axis=-1).astype(v.dtype)
    o = jnp.einsum('bhsm,bmhd->bshd', p, vh)
    return o.reshape(bsz, seq, XA_WIDTH)


def conv_ffn(x, w_up, conv_w, conv_b, w_down):
    u = causal_dwconv(x @ w_up, conv_w) + conv_b
    gate, val = jnp.split(u, 2, axis=-1)
    return (jax.nn.silu(gate) * val) @ w_down


def setup_inputs(seed: int = 0) -> dict:
    key = jax.random.key(seed)
    ks = jax.random.split(key, 24)

    def nrm(k, shape, scale):
        return jax.random.normal(k, shape, jnp.float32) * scale

    d_inv = D_MODEL ** -0.5
    return {
        "x": nrm(ks[0], (BATCH, SEQ, D_MODEL), 1.0),
        "mem": nrm(ks[1], (BATCH, N_MEM, D_MODEL), 1.0),
        "gla_w_in": nrm(ks[2], (N_GLA_LAYERS, D_MODEL, GLA_IN), d_inv),
        "gla_w_a2": nrm(ks[3], (N_GLA_LAYERS, GLA_GATE_RANK, GLA_DK), GLA_GATE_RANK ** -0.5),
        "gla_b_a": nrm(ks[4], (N_GLA_LAYERS, GLA_DK), 0.01),
        "gla_head_g": 1.0 + nrm(ks[5], (N_GLA_LAYERS, GLA_DV), 0.02),
        "gla_w_out": nrm(ks[6], (N_GLA_LAYERS, D_MODEL, D_MODEL), d_inv * DEEPNORM_BETA),
        "conv_w_in": nrm(ks[7], (N_CONV_LAYERS, D_MODEL, CONV_IN), d_inv),
        "conv_w": nrm(ks[8], (N_CONV_LAYERS, CONV_WIDTH, MIX_WIDTH), CONV_WIDTH ** -0.5),
        "conv_w_out": nrm(ks[9], (N_CONV_LAYERS, D_MODEL, D_MODEL), d_inv * DEEPNORM_BETA),
        "w_mem_kv": nrm(ks[10], (DEPTH, D_MODEL, 2 * XA_WIDTH), d_inv),
        "ln1_g": 1.0 + nrm(ks[11], (DEPTH, D_MODEL), 0.02),
        "ln1_b": nrm(ks[12], (DEPTH, D_MODEL), 0.02),
        "ffn_w_up": nrm(ks[13], (DEPTH, D_MODEL, 2 * D_FF), d_inv),
        "ffn_conv_w": nrm(ks[14], (DEPTH, FFN_CONV_WIDTH, 2 * D_FF), FFN_CONV_WIDTH ** -0.5),
        "ffn_conv_b": nrm(ks[15], (DEPTH, 2 * D_FF), 0.01),
        "ffn_w_down": nrm(ks[16], (DEPTH, D_FF, D_MODEL), (D_FF ** -0.5) * DEEPNORM_BETA),
        "ln2_g": 1.0 + nrm(ks[17], (DEPTH, D_MODEL), 0.02),
        "ln2_b": nrm(ks[18], (DEPTH, D_MODEL), 0.02),
    }


def reference(x, mem, gla_w_in, gla_w_a2, gla_b_a, gla_head_g, gla_w_out,
              conv_w_in, conv_w, conv_w_out, w_mem_kv, ln1_g, ln1_b,
              ffn_w_up, ffn_conv_w, ffn_conv_b, ffn_w_down, ln2_g, ln2_b):
    for i in range(DEPTH):
        j = i // N_MIXERS
        mem_kv = mem @ w_mem_kv[i]
        if i % N_MIXERS == 0:
            proj = x @ gla_w_in[j]
            q, k, v, r, gate_lr, mem_q = split_cols(proj, GLA_IN_SIZES)
            mix = gla_mixer(q, k, v, r, gate_lr, gla_w_a2[j], gla_b_a[j], gla_head_g[j])
            w_out = gla_w_out[j]
        else:
            proj = x @ conv_w_in[j]
            b_gate, c_gate, h, mem_q = split_cols(proj, CONV_IN_SIZES)
            mix = short_conv_mixer(b_gate, c_gate, h, conv_w[j])
            w_out = conv_w_out[j]
        xa = memory_xattn(mem_q, mem_kv)
        y = jnp.concatenate([mix, xa], axis=-1) @ w_out
        x = layer_norm(DEEPNORM_ALPHA * x + y, ln1_g[i], ln1_b[i])
        f = conv_ffn(x, ffn_w_up[i], ffn_conv_w[i], ffn_conv_b[i], ffn_w_down[i])
        x = layer_norm(DEEPNORM_ALPHA * x + f, ln2_g[i], ln2_b[i])
    return x
```

```cpp
#include <hip/hip_runtime.h>
#include <cstdio>
#include <cstdint>

#ifndef ONE_LAUNCH
#define ONE_LAUNCH 1
#endif

namespace pg8 {
#define PG8_LAS __attribute__((address_space(3)))
typedef unsigned short bf16_t;
typedef short bf16x8 __attribute__((ext_vector_type(8)));
typedef float f32x4 __attribute__((ext_vector_type(4)));
typedef unsigned u32x4 __attribute__((ext_vector_type(4)));
constexpr int BM = 256, BK = 64, HALF = 128, HTB = HALF * BK * 2  , STAGE_BYTES = 8 * HTB, NXCD = 8, WGM = 8;

__host__ __device__ __forceinline__ int lds_byte(int r, int c) { const int st = (r >> 4) * 2 + (c >> 5), rr = r & 15, cc = c & 31, ob = rr * 64 + cc * 2; return st * 1024 + (ob ^ (((ob >> 9) & 1) << 5)); }
__host__ __device__ __forceinline__ void stage_rc(int b, int& R, int& C) { const int st = b / 1024, sb = b % 1024, swz = sb ^ (((sb >> 9) & 1) << 5); R = (st >> 1) * 16 + swz / 64; C = (st & 1) * 32 + (swz % 64) / 2; }
__host__ __device__ __forceinline__ int perm32(int rho) { const int n = rho >> 4, i = rho & 15; return 8 * (i >> 2) + 4 * n + (i & 3); }

struct Unit { int pm, pn; };
struct Gemm { const bf16_t* A; const bf16_t* Bt; int M, N, K; };

struct StaticOrder {
    int nM, nN, nwg, G, c;
    __host__ __device__ void init(int M, int N, int G_, int c_) { nM = M / BM; nN = N / BM; nwg = nM * nN; G = G_; c = c_; }
    __host__ __device__ bool next(int i, Unit& u) const {
        const long L = (long)i * G + c; if (L >= nwg) return false;
        int wgid = (int)L; { const int q = nwg / NXCD, r = nwg % NXCD, xcd = wgid % NXCD, off = wgid / NXCD; wgid = (xcd < r ? xcd * (q + 1) : r * (q + 1) + (xcd - r) * q) + off; }
        const int nig = WGM * nN, gid = wgid / nig, fm = gid * WGM, gsz = (nM - fm) < WGM ? (nM - fm) : WGM;
        u.pm = fm + ((wgid % nig) % gsz); u.pn = (wgid % nig) / gsz; return true;
    }
    __device__ __forceinline__ void a_ready(const Unit&) const {}
    __device__ __forceinline__ void done(const Unit&) const {}
};


__device__ __forceinline__ unsigned cvt_pk_bf16(float lo, float hi) { unsigned r; asm volatile("v_cvt_pk_bf16_f32 %0, %1, %2" : "=v"(r) : "v"(lo), "v"(hi)); return r; }

struct EpiBf16 {
    static constexpr bool PERM = true, AFTER_DRAIN = false;
    bf16_t* O; int ldc;
    __device__ __forceinline__ void operator()(const f32x4 (&acc)[2][2][4][2], const Unit& u, int wr, int wc, int fr, int fq) const {
        const int row0 = u.pm * BM + wr * 64 + fr; const int col0 = u.pn * BM + wc * 32 + 8 * fq;
#pragma unroll
        for (int ai = 0; ai < 2; ++ai)
#pragma unroll
            for (int m = 0; m < 4; ++m) { bf16_t* rowp = O + (size_t)(row0 + ai * HALF + m * 16) * ldc + col0;
#pragma unroll
                for (int bj = 0; bj < 2; ++bj) { const f32x4 v0 = acc[ai][bj][m][0], v1 = acc[ai][bj][m][1];
                    u32x4 w; w.x = cvt_pk_bf16(v0[0], v0[1]); w.y = cvt_pk_bf16(v0[2], v0[3]); w.z = cvt_pk_bf16(v1[0], v1[1]); w.w = cvt_pk_bf16(v1[2], v1[3]);
                    *(u32x4*)(rowp + bj * HALF) = w; } }
    }
};
struct EpiResid {
    static constexpr bool PERM = false, AFTER_DRAIN = false;
    float* X; int ldc; float alpha;
    __device__ __forceinline__ void operator()(const f32x4 (&acc)[2][2][4][2], const Unit& u, int wr, int wc, int fr, int fq) const {
        const int row0 = u.pm * BM + wr * 64 + fr, col0 = u.pn * BM + wc * 32 + 4 * fq;
#pragma unroll
        for (int ai = 0; ai < 2; ++ai)
#pragma unroll
            for (int m = 0; m < 4; ++m) { float* rowp = X + (size_t)(row0 + ai * HALF + m * 16) * ldc + col0;
#pragma unroll
                for (int bj = 0; bj < 2; ++bj)
#pragma unroll
                    for (int n = 0; n < 2; ++n) { f32x4* p = (f32x4*)(rowp + bj * HALF + n * 16); const f32x4 o = *p; *p = o * alpha + acc[ai][bj][m][n]; } }
    }
};

template <class Epi, class Sched, bool ALIGN_EPI = false, bool SP2 = false>
__device__ __forceinline__ void gemm_phase(PG8_LAS unsigned char* lds, const Gemm g, const Sched& S, const Epi& E, const int tid) {
    const int wid = __builtin_amdgcn_readfirstlane(tid >> 6), lane = tid & 63, wr = wid >> 2, wc = wid & 3, fr = lane & 15, fq = lane >> 4;
    const int K = g.K, nt = K / BK;
    unsigned voffA[2], voffB[2];
#pragma unroll
    for (int i = 0; i < 2; ++i) { int R, C; stage_rc(tid * 16 + i * 8192, R, C); const int Rb = Epi::PERM ? ((R & ~31) + perm32(R & 31)) : R;
        voffA[i] = (unsigned)(R * K + C) * 2u; voffB[i] = (unsigned)(Rb * K + C) * 2u; }
    const size_t kstep = (size_t)(BK * 2);
    const size_t hstep = (size_t)HALF * K * 2;
    const size_t tstep = 2 * hstep;
    const unsigned ldsw = (unsigned)wid * 1024u;
    const int aoff = lds_byte(wr * 64 + fr, fq * 8), boff = lds_byte(wc * 32 + fr, fq * 8);
#define PG8_SA(b, h) (((b) * 2 + (h)) * HTB)
#define PG8_SB(b, h) ((4 + (b) * 2 + (h)) * HTB)
#define PG8_STAGE(bufoff, gbase, voff) do { _Pragma("unroll") for (int _i = 0; _i < 2; ++_i) \
        __builtin_amdgcn_global_load_lds((const unsigned*)((const char*)(gbase) + (voff)[_i]), (PG8_LAS unsigned*)(lds + (bufoff) + ldsw + _i * 8192), 16, 0, 0); } while (0)
#define PG8_LDA(dst, b, h) do { _Pragma("unroll") for (int m = 0; m < 4; ++m) _Pragma("unroll") for (int k = 0; k < 2; ++k) dst[m][k] = *(const PG8_LAS bf16x8*)(lds + PG8_SA(b, h) + aoff + m * 2048 + k * 1024); } while (0)
#define PG8_LDB(dst, b, h) do { _Pragma("unroll") for (int n = 0; n < 2; ++n) _Pragma("unroll") for (int k = 0; k < 2; ++k) dst[n][k] = *(const PG8_LAS bf16x8*)(lds + PG8_SB(b, h) + boff + n * 2048 + k * 1024); } while (0)
#define PG8_MMA(ai, bj, At, Bt) do { __builtin_amdgcn_s_setprio(1); _Pragma("unroll") for (int m = 0; m < 4; ++m) _Pragma("unroll") for (int n = 0; n < 2; ++n) _Pragma("unroll") for (int k = 0; k < 2; ++k) \
        acc[ai][bj][m][n] = __builtin_amdgcn_mfma_f32_16x16x32_bf16(Bt[n][k], At[m][k], acc[ai][bj][m][n], 0, 0, 0); __builtin_amdgcn_s_setprio(0); } while (0)
#define PG8_WAIT_V(n) asm volatile("s_waitcnt vmcnt(" #n ")" ::: "memory")
#define PG8_WAIT_L(n) asm volatile("s_waitcnt lgkmcnt(" #n ")" ::: "memory")
#define PG8_BAR __builtin_amdgcn_s_barrier()
#define PG8_SCHED __builtin_amdgcn_sched_barrier(0)
    Unit cur, nxt; int ui = 0;
    if (!S.next(0, cur)) return;
    f32x4 acc[2][2][4][2];
#pragma unroll
    for (int a = 0; a < 2; ++a)
#pragma unroll
        for (int b = 0; b < 2; ++b)
#pragma unroll
            for (int m = 0; m < 4; ++m)
#pragma unroll
                for (int n = 0; n < 2; ++n) acc[a][b][m][n] = (f32x4){0.f, 0.f, 0.f, 0.f};
    bf16x8 At[4][2], B0[2][2], B1[2][2];
    const char* cA = (const char*)g.A + (size_t)cur.pm * tstep; const char* cB = (const char*)g.Bt + (size_t)cur.pn * tstep;
    S.a_ready(cur);
    if constexpr (SP2) {
        PG8_STAGE(PG8_SB(0, 0), cB, voffB); PG8_STAGE(PG8_SB(0, 1), cB + hstep, voffB); PG8_STAGE(PG8_SA(0, 0), cA, voffA); PG8_STAGE(PG8_SA(0, 1), cA + hstep, voffA);
        if (wr == 1) PG8_BAR;
        PG8_WAIT_V(2); PG8_BAR;
        PG8_STAGE(PG8_SB(1, 0), cB + kstep, voffB); PG8_STAGE(PG8_SA(1, 0), cA + kstep, voffA); PG8_STAGE(PG8_SB(1, 1), cB + hstep + kstep, voffB);
        PG8_WAIT_V(6); PG8_BAR;
    } else {
        PG8_STAGE(PG8_SB(0, 0), cB, voffB); PG8_STAGE(PG8_SA(0, 0), cA, voffA); PG8_STAGE(PG8_SB(0, 1), cB + hstep, voffB); PG8_STAGE(PG8_SA(0, 1), cA + hstep, voffA);
        if (wr == 1) PG8_BAR;
        PG8_WAIT_V(4); PG8_BAR;
        PG8_STAGE(PG8_SB(1, 0), cB + kstep, voffB); PG8_STAGE(PG8_SA(1, 0), cA + kstep, voffA); PG8_STAGE(PG8_SB(1, 1), cB + hstep + kstep, voffB);
        PG8_WAIT_V(6); PG8_BAR;
    }
    for (;;) {
        const bool has_next = S.next(ui + 1, nxt);
        const char* nA = has_next ? (const char*)g.A + (size_t)nxt.pm * tstep : cA; const char* nB = has_next ? (const char*)g.Bt + (size_t)nxt.pn * tstep : cB;
        for (int t = 0; t < nt; t += 2) {
            const bool last = (t == nt - 2);
            const char* a1 = cA + (size_t)(t + 1) * kstep;
            const char* a2 = last ? nA : cA + (size_t)(t + 2) * kstep; const char* b2 = last ? nB : cB + (size_t)(t + 2) * kstep;
            const char* a3 = a2 + kstep; const char* b3 = b2 + kstep;
            if (last && has_next) S.a_ready(nxt);
            if constexpr (SP2) {
            PG8_LDB(B0, 0, 0); PG8_LDB(B1, 0, 1); PG8_SCHED; PG8_LDA(At, 0, 0); PG8_STAGE(PG8_SA(1, 1), a1 + hstep, voffA);
            PG8_WAIT_V(8); PG8_WAIT_L(0); PG8_BAR; PG8_MMA(0, 0, At, B0); PG8_MMA(0, 1, At, B1); PG8_BAR; PG8_SCHED;
            PG8_LDA(At, 0, 1); PG8_STAGE(PG8_SB(0, 0), b2, voffB); PG8_STAGE(PG8_SB(0, 1), b2 + hstep, voffB); PG8_STAGE(PG8_SA(0, 0), a2, voffA);
            PG8_WAIT_V(8); PG8_WAIT_L(0); PG8_BAR; PG8_MMA(1, 0, At, B0); PG8_MMA(1, 1, At, B1); PG8_BAR; PG8_SCHED;
            PG8_LDB(B0, 1, 0); PG8_LDB(B1, 1, 1); PG8_SCHED; PG8_LDA(At, 1, 0); PG8_STAGE(PG8_SA(0, 1), a2 + hstep, voffA);
            PG8_WAIT_V(8); PG8_WAIT_L(0); PG8_BAR; PG8_MMA(0, 0, At, B0); PG8_MMA(0, 1, At, B1); PG8_BAR; PG8_SCHED;
            PG8_LDA(At, 1, 1); PG8_STAGE(PG8_SB(1, 0), b3, voffB); PG8_STAGE(PG8_SB(1, 1), b3 + hstep, voffB); PG8_STAGE(PG8_SA(1, 0), a3, voffA);
            PG8_WAIT_V(8); PG8_WAIT_L(0); PG8_BAR; PG8_MMA(1, 0, At, B0); PG8_MMA(1, 1, At, B1); PG8_BAR; PG8_SCHED;
            } else {
            PG8_LDB(B0, 0, 0); PG8_SCHED; PG8_LDA(At, 0, 0); PG8_STAGE(PG8_SA(1, 1), a1 + hstep, voffA);
            PG8_WAIT_L(8); PG8_BAR; PG8_WAIT_L(0); PG8_MMA(0, 0, At, B0); PG8_BAR; PG8_SCHED;
            PG8_LDB(B1, 0, 1); PG8_STAGE(PG8_SB(0, 0), b2, voffB);
            PG8_BAR; PG8_WAIT_L(0); PG8_MMA(0, 1, At, B1); PG8_BAR;
            PG8_LDA(At, 0, 1); PG8_STAGE(PG8_SA(0, 0), a2, voffA);
            PG8_BAR; PG8_WAIT_L(0); PG8_MMA(1, 0, At, B0); PG8_BAR; PG8_SCHED;
            PG8_STAGE(PG8_SB(0, 1), b2 + hstep, voffB);
            PG8_WAIT_V(6); PG8_BAR; PG8_MMA(1, 1, At, B1); PG8_BAR;
            PG8_LDB(B0, 1, 0); PG8_SCHED; PG8_LDA(At, 1, 0); PG8_STAGE(PG8_SA(0, 1), a2 + hstep, voffA);
            PG8_WAIT_L(8); PG8_BAR; PG8_WAIT_L(0); PG8_MMA(0, 0, At, B0); PG8_BAR; PG8_SCHED;
            PG8_LDB(B1, 1, 1); PG8_STAGE(PG8_SB(1, 0), b3, voffB);
            PG8_BAR; PG8_WAIT_L(0); PG8_MMA(0, 1, At, B1); PG8_BAR;
            PG8_LDA(At, 1, 1); PG8_STAGE(PG8_SA(1, 0), a3, voffA);
            PG8_BAR; PG8_WAIT_L(0); PG8_MMA(1, 0, At, B0); PG8_BAR; PG8_SCHED;
            PG8_STAGE(PG8_SB(1, 1), b3 + hstep, voffB);
            PG8_WAIT_V(6); PG8_BAR; PG8_MMA(1, 1, At, B1); PG8_BAR;
            }
        }
        if constexpr (ALIGN_EPI) { if (wr == 0) PG8_BAR; }
        if constexpr (!Epi::AFTER_DRAIN) { E(acc, cur, wr, wc, fr, fq); S.done(cur); }
        if (!has_next) break;
#pragma unroll
        for (int a = 0; a < 2; ++a)
#pragma unroll
            for (int b = 0; b < 2; ++b)
#pragma unroll
                for (int m = 0; m < 4; ++m)
#pragma unroll
                    for (int n = 0; n < 2; ++n) acc[a][b][m][n] = (f32x4){0.f, 0.f, 0.f, 0.f};
        cur = nxt; cA = nA; cB = nB; ++ui;
        if constexpr (ALIGN_EPI) { if (wr == 1) PG8_BAR; }
    }
    PG8_WAIT_V(0);
    if constexpr (!ALIGN_EPI) { if (wr == 0) PG8_BAR; }
    PG8_BAR;
    if constexpr (Epi::AFTER_DRAIN) { E.fused(acc, cur, wr, wc, fr, fq, lds, wid, lane); S.done(cur); }
#undef PG8_SA
#undef PG8_SB
#undef PG8_STAGE
#undef PG8_LDA
#undef PG8_LDB
#undef PG8_MMA
#undef PG8_WAIT_V
#undef PG8_WAIT_L
#undef PG8_BAR
#undef PG8_SCHED
}
}

constexpr int NWAVES = 8;
constexpr int BATCH = 8, SEQ = 2048, D = 1024, DEPTH = 4;
constexpr int M = BATCH * SEQ;
constexpr int NMEM = 256, MM = BATCH * NMEM;
constexpr int XAW = 256, XAH = 4, XAD = 64, MIXW = 768;
constexpr int GH = 4, GDK = 384, GDV = 768, GHK = 96, GHV = 192, RANK = 16, CH = 64, NCH = SEQ / CH;
constexpr int DFF = 2816, DFF2 = 5632;
constexpr int GLA_IN = 2576, CONV_IN = 2560, LDP = 2816;
constexpr float LN_EPS = 1e-5f;
constexpr float DN_ALPHA = 1.6817928305074292f;
constexpr int PC_Q = 0, PC_K = 384, PC_V = 768, PC_R = 1536, PC_MQ = 2304, PC_GATE = 2560;
constexpr int PC_B = 0, PC_C = 768, PC_H = 1536;
constexpr int NUNITS_GLA = BATCH * GH * NCH;

constexpr size_t MiB = 1u << 20;
constexpr size_t WS_CTL = 0, CTL_ZERO_BYTES = 1 * MiB;
constexpr size_t WS_WIN = 1 * MiB;
constexpr size_t WS_WOUT = WS_WIN + 5 * MiB + MiB / 2;
constexpr size_t WS_WUP = WS_WOUT + 2 * MiB;
constexpr size_t WS_WDN = WS_WUP + 11 * MiB;
constexpr size_t WS_WMKV = WS_WDN + 5 * MiB + MiB / 2;
constexpr size_t WS_XN = 27 * MiB;
constexpr size_t WS_PROJ = 60 * MiB;
constexpr size_t WS_ABUF = 148 * MiB;
constexpr size_t WS_GB = 180 * MiB;
constexpr size_t WS_MEMKV = 204 * MiB;
constexpr size_t WS_U = 60 * MiB;
constexpr size_t WS_H = 236 * MiB;
constexpr size_t WS_ST = 236 * MiB;
constexpr size_t WS_DEC = 308 * MiB;
constexpr size_t WS_MEMB = 324 * MiB;
constexpr size_t WS_END = 328 * MiB;
static_assert(WS_WMKV + 1 * MiB <= WS_XN && WS_U + (size_t)M * DFF2 * 2 <= WS_H && WS_DEC + (size_t)NUNITS_GLA * GHK * 4 <= WS_MEMB, "d_ws map");
constexpr int CW_BAR = 4096;

constexpr int LDS_BYTES = 163840;
constexpr int RING_OFF = 0;
constexpr int MISC_OFF = 163840 - 256;
constexpr int PTAB_OFF = 163840 - 512;

#define GAS __attribute__((address_space(1)))
#define LAS __attribute__((address_space(3)))
typedef unsigned short bf16;
typedef unsigned v4u __attribute__((ext_vector_type(4)));
typedef unsigned v2u __attribute__((ext_vector_type(2)));
typedef float f32x4 __attribute__((ext_vector_type(4)));
typedef GAS unsigned gu32;
#define RLX_AGENT __ATOMIC_RELAXED, __HIP_MEMORY_SCOPE_AGENT
#define LDS_WAIT() asm volatile("s_waitcnt lgkmcnt(0)" ::: "memory")
__device__ __forceinline__ unsigned f2bf(float f) { unsigned u = __builtin_bit_cast(unsigned, f); return (u + 0x7fffu + ((u >> 16) & 1u)) >> 16; }
__device__ __forceinline__ unsigned pk2(float lo, float hi) { return f2bf(lo) | (f2bf(hi) << 16); }
__device__ __forceinline__ float bf2f(unsigned short b) { return __uint_as_float(((unsigned)b) << 16); }
__device__ __forceinline__ float bflo(unsigned w) { return __uint_as_float(w << 16); }
__device__ __forceinline__ float bfhi(unsigned w) { return __uint_as_float(w & 0xffff0000u); }
__device__ __forceinline__ float wave_sum(float v) {
#pragma unroll
    for (int o = 1; o < 64; o <<= 1) v += __shfl_xor(v, o);
    return v;
}
__device__ __forceinline__ float wave_max(float v) {
#pragma unroll
    for (int o = 1; o < 64; o <<= 1) v = fmaxf(v, __shfl_xor(v, o));
    return v;
}
#define XB_TMO      128
#define XB_XCNT(j)  (256  + 64 * (j))
#define XB_XSUB(j)  (1280 + 64 * (j))
#define XB_XGEN(j)  (2304 + 64 * (j))
#define XB_TOP      3328
#define XB_TOPGEN   3392
#define XCD_BAR_WORDS 3456
#define XB_SPIN_CAP (1u << 18)

__device__ __forceinline__ unsigned xb_ld(unsigned* p)              { return __hip_atomic_load(p, __ATOMIC_RELAXED, __HIP_MEMORY_SCOPE_AGENT); }
__device__ __forceinline__ unsigned xb_add(unsigned* p, unsigned v) { return __hip_atomic_fetch_add(p, v, __ATOMIC_RELAXED, __HIP_MEMORY_SCOPE_AGENT); }
__device__ __forceinline__ unsigned xb_xcc_id() { return (unsigned)__builtin_amdgcn_s_getreg((3 << 11) | 20) & 0xFu; }
#define XB_SPIN(cond, bar) do { unsigned _sp = 0; while (cond) { __builtin_amdgcn_s_sleep(1); \
    if ((++_sp & 255u) == 0u) { if (xb_ld(&(bar)[XB_TMO])) break; if (_sp > XB_SPIN_CAP) { atomicAdd(&(bar)[XB_TMO], 1u); break; } } } } while (0)

struct XcdBarrier {
    unsigned* bar; unsigned x;
    volatile LAS unsigned* st;
};

__device__ __forceinline__ XcdBarrier xcd_barrier_post(unsigned* bar, volatile LAS unsigned* st) {
    XcdBarrier b; b.bar = bar; b.x = xb_xcc_id(); b.st = st;
    if (threadIdx.x == 0) (void)xb_add(&bar[XB_XCNT(b.x)], 1u);
    return b;
}
__device__ __forceinline__ void xcd_barrier_complete(unsigned* bar, unsigned x, unsigned& nloc, unsigned& nx) {
    const unsigned G = gridDim.x * gridDim.y * gridDim.z;
    unsigned sum, cnt, mine, sp = 0u;
    for (;;) {
        sum = 0u; cnt = 0u; mine = 0u;
#pragma unroll
        for (unsigned j = 0; j < 16; ++j) { const unsigned c = xb_ld(&bar[XB_XCNT(j)]); sum += c; cnt += (c > 0u) ? 1u : 0u; mine = (j == x) ? c : mine; }
        if (sum == G) break;
        __builtin_amdgcn_s_sleep(1);
        if ((++sp & 255u) == 0u) { if (xb_ld(&bar[XB_TMO])) break; if (sp > XB_SPIN_CAP) { atomicAdd(&bar[XB_TMO], 1u); break; } }
    }
    nloc = mine > 0u ? mine : 1u; nx = cnt > 0u ? cnt : 1u;
}

__device__ __forceinline__ void xcd_barrier(const XcdBarrier& b) {
    asm volatile("s_waitcnt vmcnt(0)" ::: "memory");
    __syncthreads();
    if (threadIdx.x == 0) {
        unsigned* bar = b.bar;
        __builtin_amdgcn_s_waitcnt(0);
        unsigned nloc = b.st[0], nx = b.st[1];
        if (nloc == 0u) { xcd_barrier_complete(bar, b.x, nloc, nx); b.st[0] = nloc; b.st[1] = nx; }
        const unsigned old = xb_add(&bar[XB_XSUB(b.x)], 1u);
        const unsigned gen = old / nloc;
        if (old + 1u == (gen + 1u) * nloc) {
            __builtin_amdgcn_fence(__ATOMIC_RELEASE, "agent");
            asm volatile("s_waitcnt vmcnt(0)" ::: "memory");
            const unsigned og = xb_add(&bar[XB_TOP], 1u);
            const unsigned tg = og / nx;
            if (og + 1u == (tg + 1u) * nx) xb_add(&bar[XB_TOPGEN], 1u);
            else XB_SPIN(xb_ld(&bar[XB_TOPGEN]) == tg, bar);
            __builtin_amdgcn_fence(__ATOMIC_ACQUIRE, "agent");
            xb_add(&bar[XB_XGEN(b.x)], 1u);
            asm volatile("s_waitcnt vmcnt(0)" ::: "memory");
        } else {
            XB_SPIN(xb_ld(&bar[XB_XGEN(b.x)]) == gen, bar);
            __builtin_amdgcn_fence(__ATOMIC_ACQUIRE, "agent");
            asm volatile("s_waitcnt vmcnt(0)" ::: "memory");
        }
    }
    __syncthreads();
}

#ifndef SKIPMASK
#define SKIPMASK 0
#endif
__device__ __forceinline__ int dest_row(int mode, int n) {
    if (mode == 1) return n < 2304 ? n : (n < 2320 ? n + 256 : n - 16);
    return n;
}
__device__ __forceinline__ void transpose_item(const float* W, int K, int N, bf16* WT, int mode, LAS float* scr, int item, int lane) {
    const int nblk = (N + 31) / 32, kb = item / nblk, nb = item % nblk, k0 = 64 * kb, n0 = 32 * nb;
    const int nn = n0 + (lane & 31);
#pragma unroll 8
    for (int i = 0; i < 32; ++i) { const int kk = 2 * i + (lane >> 5); scr[kk * 33 + (lane & 31)] = (nn < N) ? W[(size_t)(k0 + kk) * N + nn] : 0.f; }
    LDS_WAIT(); asm volatile("" ::: "memory");
    const int c = lane & 7;
#pragma unroll
    for (int j = 0; j < 4; ++j) { const int n = (lane >> 3) + 8 * j; const LAS float* s = scr + (8 * c) * 33 + n;
        v4u o; o.x = pk2(s[0 * 33], s[1 * 33]); o.y = pk2(s[2 * 33], s[3 * 33]); o.z = pk2(s[4 * 33], s[5 * 33]); o.w = pk2(s[6 * 33], s[7 * 33]);
        if (n0 + n < N) *(GAS v4u*)(WT + (size_t)dest_row(mode, n0 + n) * K + k0 + 8 * c) = o; }
    LDS_WAIT(); asm volatile("" ::: "memory");
}

struct Ptrs {
    const float *x, *mem, *gla_w_in, *gla_w_a2, *gla_b_a, *gla_head_g, *gla_w_out, *conv_w_in, *conv_w, *conv_w_out, *w_mem_kv, *ln1_g, *ln1_b, *ffn_w_up, *ffn_conv_w, *ffn_conv_b, *ffn_w_down, *ln2_g, *ln2_b;
    float* xres;
    bf16 *win, *wout, *wup, *wdn, *wmkv, *xn, *proj, *abuf, *memkv, *u, *h, *memb;
    float *gb, *st, *dec;
};
__device__ __forceinline__ const float* gp(const LAS unsigned long long* PT, int k) {
    const unsigned long long v = PT[k];
    const unsigned lo = __builtin_amdgcn_readfirstlane((unsigned)v), hi = __builtin_amdgcn_readfirstlane((unsigned)(v >> 32));
    return (const float*)(const GAS float*)(((unsigned long long)hi << 32) | lo);
}
__device__ __forceinline__ void load_ptrs(Ptrs& P, const LAS unsigned long long* PT, unsigned char* ws_) {
    asm volatile("" ::: "memory");
    unsigned char* ws = (unsigned char*)(GAS unsigned char*)ws_;
    P.x = gp(PT, 0); P.mem = gp(PT, 1); P.gla_w_in = gp(PT, 2); P.gla_w_a2 = gp(PT, 3); P.gla_b_a = gp(PT, 4); P.gla_head_g = gp(PT, 5); P.gla_w_out = gp(PT, 6);
    P.conv_w_in = gp(PT, 7); P.conv_w = gp(PT, 8); P.conv_w_out = gp(PT, 9); P.w_mem_kv = gp(PT, 10); P.ln1_g = gp(PT, 11); P.ln1_b = gp(PT, 12);
    P.ffn_w_up = gp(PT, 13); P.ffn_conv_w = gp(PT, 14); P.ffn_conv_b = gp(PT, 15); P.ffn_w_down = gp(PT, 16); P.ln2_g = gp(PT, 17); P.ln2_b = gp(PT, 18);
    P.xres = (float*)gp(PT, 19);
    P.win = (bf16*)(ws + WS_WIN); P.wout = (bf16*)(ws + WS_WOUT); P.wup = (bf16*)(ws + WS_WUP); P.wdn = (bf16*)(ws + WS_WDN); P.wmkv = (bf16*)(ws + WS_WMKV);
    P.xn = (bf16*)(ws + WS_XN); P.proj = (bf16*)(ws + WS_PROJ); P.abuf = (bf16*)(ws + WS_ABUF); P.memkv = (bf16*)(ws + WS_MEMKV); P.u = (bf16*)(ws + WS_U); P.h = (bf16*)(ws + WS_H); P.memb = (bf16*)(ws + WS_MEMB);
    P.gb = (float*)(ws + WS_GB); P.st = (float*)(ws + WS_ST); P.dec = (float*)(ws + WS_DEC);
}

__device__ __forceinline__ void ph_convert(const Ptrs& P, int l, LAS unsigned char* lds, int gw, int NGW, int lane, int gtid, int NT) {
    if (SKIPMASK & 2) return;
    LAS float* scr = (LAS float*)(lds + (gw % NWAVES) * 16384);
    const bool gla = (l & 1) == 0; const int j = l >> 1;
    const float* Win = gla ? P.gla_w_in + (size_t)j * D * GLA_IN : P.conv_w_in + (size_t)j * D * CONV_IN; const int Nin = gla ? GLA_IN : CONV_IN;
    const float* Wout = gla ? P.gla_w_out + (size_t)j * D * D : P.conv_w_out + (size_t)j * D * D;
    const float* Wup = P.ffn_w_up + (size_t)l * D * DFF2; const float* Wdn = P.ffn_w_down + (size_t)l * DFF * D; const float* Wmkv = P.w_mem_kv + (size_t)l * D * 512;
    const int I_IN = (D / 64) * ((Nin + 31) / 32), I_OUT = (D / 64) * (D / 32), I_UP = (D / 64) * (DFF2 / 32), I_DN = (DFF / 64) * (D / 32), I_MKV = (D / 64) * (512 / 32);
    const int total = I_IN + I_OUT + I_UP + I_DN + I_MKV;
    for (int it = gw; it < total; it += NGW) {
        int r = it;
        if (r < I_IN) { transpose_item(Win, D, Nin, P.win, gla ? 1 : 0, scr, r, lane); continue; } r -= I_IN;
        if (r < I_OUT) { transpose_item(Wout, D, D, P.wout, 0, scr, r, lane); continue; } r -= I_OUT;
        if (r < I_UP) { transpose_item(Wup, D, DFF2, P.wup, 0, scr, r, lane); continue; } r -= I_UP;
        if (r < I_DN) { transpose_item(Wdn, DFF, D, P.wdn, 0, scr, r, lane); continue; } r -= I_DN;
        transpose_item(Wmkv, D, 512, P.wmkv, 0, scr, r, lane);
    }
    if (gla) { GAS v4u* z = (GAS v4u*)(P.win + (size_t)GLA_IN * D); for (int i = gtid; i < (LDP - GLA_IN) * D * 2 / 16; i += NT) z[i] = (v4u){0u, 0u, 0u, 0u}; }
}

__device__ __forceinline__ void ph_prologue(const Ptrs& P, int gtid, int NT) {
    if (SKIPMASK & 1) return;
    for (int i = gtid; i < M * D / 4; i += NT) { const f32x4 v = ((const GAS f32x4*)P.x)[i]; ((GAS f32x4*)P.xres)[i] = v; v2u w; w.x = pk2(v.x, v.y); w.y = pk2(v.z, v.w); ((GAS v2u*)P.xn)[i] = w; }
    for (int i = gtid; i < MM * D / 4; i += NT) { const f32x4 v = ((const GAS f32x4*)P.mem)[i]; v2u w; w.x = pk2(v.x, v.y); w.y = pk2(v.z, v.w); ((GAS v2u*)P.memb)[i] = w; }
}

__device__ __forceinline__ void ph_ln(const Ptrs& P, const float* g, const float* b, int gw, int NGW, int lane) {
    if (SKIPMASK & 4) return;
    for (int m = gw; m < M; m += NGW) {
        GAS f32x4* xr = (GAS f32x4*)(P.xres + (size_t)m * D) + lane;
        f32x4 v[4]; float s = 0.f;
#pragma unroll
        for (int j = 0; j < 4; ++j) { v[j] = xr[64 * j]; s += (v[j].x + v[j].y) + (v[j].z + v[j].w); }
        const float mean = wave_sum(s) * (1.f / D); float s2 = 0.f;
#pragma unroll
        for (int j = 0; j < 4; ++j) { v[j] = v[j] - mean; s2 += (v[j].x * v[j].x + v[j].y * v[j].y) + (v[j].z * v[j].z + v[j].w * v[j].w); }
        const float rstd = 1.f / sqrtf(wave_sum(s2) * (1.f / D) + LN_EPS);
        GAS v2u* o8 = (GAS v2u*)(P.xn + (size_t)m * D) + lane;
#pragma unroll
        for (int j = 0; j < 4; ++j) { const f32x4 gg = ((const GAS f32x4*)g)[lane + 64 * j], bb = ((const GAS f32x4*)b)[lane + 64 * j];
            const f32x4 o = v[j] * rstd * gg + bb; xr[64 * j] = o; v2u w; w.x = pk2(o.x, o.y); w.y = pk2(o.z, o.w); o8[64 * j] = w; }
    }
}

__device__ __forceinline__ void ph_gla_g(const Ptrs& P, int j, int gtid, int NT) {
    if (SKIPMASK & 8) return;
    for (int idx = gtid; idx < (M / CH) * GDK; idx += NT) {
        const int c = idx % GDK, t0 = (idx / GDK) * CH;
        float w[RANK];
#pragma unroll
        for (int r = 0; r < RANK; ++r) w[r] = P.gla_w_a2[((size_t)j * RANK + r) * GDK + c];
        const float bias = P.gla_b_a[(size_t)j * GDK + c];
        float G = 0.f;
        for (int t = 0; t < CH; ++t) {
            const GAS v4u* gp = (const GAS v4u*)(P.proj + (size_t)(t0 + t) * LDP + PC_GATE);
            const v4u g0 = gp[0], g1 = gp[1];
            float z = bias;
            z += bflo(g0.x) * w[0] + bfhi(g0.x) * w[1] + bflo(g0.y) * w[2] + bfhi(g0.y) * w[3] + bflo(g0.z) * w[4] + bfhi(g0.z) * w[5] + bflo(g0.w) * w[6] + bfhi(g0.w) * w[7];
            z += bflo(g1.x) * w[8] + bfhi(g1.x) * w[9] + bflo(g1.y) * w[10] + bfhi(g1.y) * w[11] + bflo(g1.z) * w[12] + bfhi(g1.z) * w[13] + bflo(g1.w) * w[14] + bfhi(g1.w) * w[15];
            const float ls = fminf(z, 0.f) - log1pf(expf(-fabsf(z)));
            G += ls * (1.0f / 16.0f);
            P.gb[(size_t)(t0 + t) * GDK + c] = G;
        }
    }
}

__device__ __forceinline__ void ph_gla_kv(const Ptrs& P, LAS unsigned char* lds, int tid, int bid, int G) {
    if (SKIPMASK & 16) return;
    LAS float* KE = (LAS float*)lds;
    LAS float* VL = (LAS float*)(lds + 64 * 96 * 4);
    for (int u = bid; u < NUNITS_GLA; u += G) {
        const int b = u / (GH * NCH), h = (u / NCH) % GH, n = u % NCH, t0 = b * SEQ + n * CH;
        for (int e = tid; e < CH * GHK; e += 512) { const int t = e / GHK, i = e % GHK;
            const float g = P.gb[(size_t)(t0 + t) * GDK + h * GHK + i], gl = P.gb[(size_t)(t0 + CH - 1) * GDK + h * GHK + i];
            KE[e] = bf2f(P.proj[(size_t)(t0 + t) * LDP + PC_K + h * GHK + i]) * expf(gl - g); }
        for (int e = tid; e < CH * GHV; e += 512) { const int t = e / GHV, v = e % GHV; VL[e] = bf2f(P.proj[(size_t)(t0 + t) * LDP + PC_V + h * GHV + v]); }
        if (tid < GHK) P.dec[(size_t)u * GHK + tid] = expf(P.gb[(size_t)(t0 + CH - 1) * GDK + h * GHK + tid]);
        __syncthreads();
        const int vb = tid & 31, ib = tid >> 5;
        float acc[6][6];
#pragma unroll
        for (int a = 0; a < 6; ++a)
#pragma unroll
            for (int c = 0; c < 6; ++c) acc[a][c] = 0.f;
        for (int t = 0; t < CH; ++t) {
            float vv[6], kk[6];
#pragma unroll
            for (int a = 0; a < 6; ++a) vv[a] = VL[t * GHV + vb + 32 * a];
#pragma unroll
            for (int c = 0; c < 6; ++c) kk[c] = KE[t * GHK + ib * 6 + c];
#pragma unroll
            for (int a = 0; a < 6; ++a)
#pragma unroll
                for (int c = 0; c < 6; ++c) acc[a][c] += vv[a] * kk[c];
        }
        float* so = P.st + (size_t)u * (GHV * GHK);
#pragma unroll
        for (int a = 0; a < 6; ++a)
#pragma unroll
            for (int c = 0; c < 6; ++c) so[(vb + 32 * a) * GHK + ib * 6 + c] = acc[a][c];
        __syncthreads();
    }
}

__device__ __forceinline__ void ph_gla_scan(const Ptrs& P, int gtid, int NT) {
    if (SKIPMASK & 32) return;
    constexpr int E = GHV * GHK;
    for (int idx = gtid; idx < BATCH * GH * E; idx += NT) {
        const int e = idx % E, bh = idx / E, i = e % GHK;
        float S = 0.f;
        for (int n = 0; n < NCH; ++n) { const size_t off = (size_t)(bh * NCH + n) * E + e; const float kvv = P.st[off]; P.st[off] = S; S = P.dec[(size_t)(bh * NCH + n) * GHK + i] * S + kvv; }
    }
}

__device__ __forceinline__ void ph_gla_out(const Ptrs& P, int j, LAS unsigned char* lds, int tid, int bid, int G) {
    if (SKIPMASK & 64) return;
    LAS float* QD = (LAS float*)lds;
    LAS float* KI = (LAS float*)(lds + 64 * 97 * 4);
    LAS float* AT = (LAS float*)(lds + 2 * 64 * 97 * 4);
    LAS float* VL = (LAS float*)(lds + 2 * 64 * 97 * 4 + 64 * 65 * 4);
    const int lane = tid & 63, wave = tid >> 6;
    const float scale = 0.10206207261596577f;
    for (int u = bid; u < NUNITS_GLA; u += G) {
        const int b = u / (GH * NCH), h = (u / NCH) % GH, n = u % NCH, t0 = b * SEQ + n * CH;
        for (int e = tid; e < CH * GHK; e += 512) { const int t = e / GHK, i = e % GHK;
            const float g = P.gb[(size_t)(t0 + t) * GDK + h * GHK + i];
            const float q = bf2f(P.proj[(size_t)(t0 + t) * LDP + PC_Q + h * GHK + i]), k = bf2f(P.proj[(size_t)(t0 + t) * LDP + PC_K + h * GHK + i]);
            QD[t * 97 + i] = q * scale * expf(g); KI[t * 97 + i] = k * expf(-g); }
        for (int e = tid; e < CH * GHV; e += 512) { const int t = e / GHV, v = e % GHV; VL[e] = bf2f(P.proj[(size_t)(t0 + t) * LDP + PC_V + h * GHV + v]); }
        __syncthreads();
        {
            float a[8];
#pragma unroll
            for (int r = 0; r < 8; ++r) a[r] = 0.f;
            for (int k = 0; k < GHK; ++k) { const float kv = KI[lane * 97 + k];
#pragma unroll
                for (int r = 0; r < 8; ++r) a[r] += QD[(wave * 8 + r) * 97 + k] * kv; }
#pragma unroll
            for (int r = 0; r < 8; ++r) AT[(wave * 8 + r) * 65 + lane] = (lane <= wave * 8 + r) ? a[r] : 0.f;
        }
        __syncthreads();
        float o[8][3];
#pragma unroll
        for (int r = 0; r < 8; ++r)
#pragma unroll
            for (int a = 0; a < 3; ++a) o[r][a] = 0.f;
        for (int jj = 0; jj < CH; ++jj) { float vv[3];
#pragma unroll
            for (int a = 0; a < 3; ++a) vv[a] = VL[jj * GHV + lane + 64 * a];
#pragma unroll
            for (int r = 0; r < 8; ++r) { const float at = AT[(wave * 8 + r) * 65 + jj];
#pragma unroll
                for (int a = 0; a < 3; ++a) o[r][a] += at * vv[a]; } }
        const float* sp = P.st + (size_t)u * (GHV * GHK);
        for (int k = 0; k < GHK; k += 4) { f32x4 sv[3];
#pragma unroll
            for (int a = 0; a < 3; ++a) sv[a] = *(const GAS f32x4*)(sp + (size_t)(lane + 64 * a) * GHK + k);
#pragma unroll
            for (int r = 0; r < 8; ++r) { const float q0 = QD[(wave * 8 + r) * 97 + k], q1 = QD[(wave * 8 + r) * 97 + k + 1], q2 = QD[(wave * 8 + r) * 97 + k + 2], q3 = QD[(wave * 8 + r) * 97 + k + 3];
#pragma unroll
                for (int a = 0; a < 3; ++a) o[r][a] += q0 * sv[a].x + q1 * sv[a].y + q2 * sv[a].z + q3 * sv[a].w; } }
#pragma unroll
        for (int r = 0; r < 8; ++r) {
            const float ss = wave_sum(o[r][0] * o[r][0] + o[r][1] * o[r][1] + o[r][2] * o[r][2]);
            const float rs = 1.f / sqrtf(ss * (1.f / GHV) + LN_EPS);
            const size_t row = (size_t)(t0 + wave * 8 + r);
#pragma unroll
            for (int a = 0; a < 3; ++a) { const int col = h * GHV + lane + 64 * a;
                const float rr = bf2f(P.proj[row * LDP + PC_R + col]);
                const float val = o[r][a] * rs * P.gla_head_g[(size_t)j * GDV + col] * (rr / (1.f + expf(-rr)));
                P.abuf[row * D + col] = (bf16)f2bf(val); }
        }
        __syncthreads();
    }
}

__device__ __forceinline__ void ph_conv_mix(const Ptrs& P, int j, int gtid, int NT) {
    if (SKIPMASK & 128) return;
    const float* w = P.conv_w + (size_t)j * 3 * MIXW;
    for (int idx = gtid; idx < M * (MIXW / 8); idx += NT) {
        const int cg = idx % (MIXW / 8), t = idx / (MIXW / 8), c0 = cg * 8, pos = t % SEQ;
        float y[8];
#pragma unroll
        for (int e = 0; e < 8; ++e) y[e] = 0.f;
#pragma unroll
        for (int k = 0; k < 3; ++k) {
            if (pos - 2 + k < 0) continue;
            const size_t row = (size_t)(t - 2 + k);
            const v4u cc = *(const GAS v4u*)(P.proj + row * LDP + PC_C + c0), hh = *(const GAS v4u*)(P.proj + row * LDP + PC_H + c0);
            const f32x4 w0 = *(const GAS f32x4*)(w + k * MIXW + c0), w1 = *(const GAS f32x4*)(w + k * MIXW + c0 + 4);
            y[0] += w0.x * (bflo(cc.x) * bflo(hh.x)); y[1] += w0.y * (bfhi(cc.x) * bfhi(hh.x)); y[2] += w0.z * (bflo(cc.y) * bflo(hh.y)); y[3] += w0.w * (bfhi(cc.y) * bfhi(hh.y));
            y[4] += w1.x * (bflo(cc.z) * bflo(hh.z)); y[5] += w1.y * (bfhi(cc.z) * bfhi(hh.z)); y[6] += w1.z * (bflo(cc.w) * bflo(hh.w)); y[7] += w1.w * (bfhi(cc.w) * bfhi(hh.w));
        }
        const v4u bb = *(const GAS v4u*)(P.proj + (size_t)t * LDP + PC_B + c0);
        v4u o; o.x = pk2(bflo(bb.x) * y[0], bfhi(bb.x) * y[1]); o.y = pk2(bflo(bb.y) * y[2], bfhi(bb.y) * y[3]); o.z = pk2(bflo(bb.z) * y[4], bfhi(bb.z) * y[5]); o.w = pk2(bflo(bb.w) * y[6], bfhi(bb.w) * y[7]);
        *(GAS v4u*)(P.abuf + (size_t)t * D + c0) = o;
    }
}

__device__ __forceinline__ void ph_xattn(const Ptrs& P, LAS unsigned char* lds, int tid, int bid, int G) {
    if (SKIPMASK & 256) return;
    LAS float* KL = (LAS float*)lds;
    LAS float* VL = (LAS float*)(lds + 256 * 65 * 4);
    LAS float* PL = (LAS float*)(lds + 256 * 65 * 4 + 256 * 64 * 4);
    LAS float* QL = (LAS float*)(lds + 256 * 65 * 4 + 256 * 64 * 4 + 8 * 256 * 4);
    const int lane = tid & 63, wave = tid >> 6;
    for (int u = bid; u < BATCH * XAH * (SEQ / 256); u += G) {
        const int b = u / (XAH * (SEQ / 256)), h = (u / (SEQ / 256)) % XAH, tb = u % (SEQ / 256);
        for (int e = tid; e < NMEM * XAD; e += 512) { const int m = e / XAD, d = e % XAD; const size_t r = (size_t)(b * NMEM + m) * 512;
            KL[m * 65 + d] = bf2f(P.memkv[r + h * XAD + d]); VL[m * 64 + d] = bf2f(P.memkv[r + 256 + h * XAD + d]); }
        __syncthreads();
        for (int tt = 0; tt < 32; ++tt) {
            const size_t t = (size_t)b * SEQ + tb * 256 + wave * 32 + tt;
            QL[wave * 64 + lane] = bf2f(P.proj[t * LDP + PC_MQ + h * XAD + lane]);
            LDS_WAIT(); asm volatile("" ::: "memory");
            float s[4] = {0.f, 0.f, 0.f, 0.f};
            for (int d = 0; d < XAD; ++d) { const float q = QL[wave * 64 + d];
#pragma unroll
                for (int c = 0; c < 4; ++c) s[c] += q * KL[(lane + 64 * c) * 65 + d]; }
#pragma unroll
            for (int c = 0; c < 4; ++c) s[c] *= 0.125f;
            const float mx = wave_max(fmaxf(fmaxf(s[0], s[1]), fmaxf(s[2], s[3])));
            float p[4], ps = 0.f;
#pragma unroll
            for (int c = 0; c < 4; ++c) { p[c] = expf(s[c] - mx); ps += p[c]; PL[wave * 256 + lane + 64 * c] = p[c]; }
            ps = wave_sum(ps);
            LDS_WAIT(); asm volatile("" ::: "memory");
            float o = 0.f;
            for (int m = 0; m < NMEM; ++m) o += PL[wave * 256 + m] * VL[m * 64 + lane];
            P.abuf[t * D + MIXW + h * XAD + lane] = (bf16)f2bf(o / ps);
            LDS_WAIT(); asm volatile("" ::: "memory");
        }
        __syncthreads();
    }
}

__device__ __forceinline__ void ph_convgate(const Ptrs& P, int l, int gtid, int NT) {
    if (SKIPMASK & 512) return;
    const float* w = P.ffn_conv_w + (size_t)l * 3 * DFF2; const float* bs = P.ffn_conv_b + (size_t)l * DFF2;
    for (int idx = gtid; idx < M * (DFF / 8); idx += NT) {
        const int cg = idx % (DFF / 8), t = idx / (DFF / 8), c0 = cg * 8, pos = t % SEQ;
        float yg[8], yv[8];
        { const f32x4 a0 = *(const GAS f32x4*)(bs + c0), a1 = *(const GAS f32x4*)(bs + c0 + 4), b0 = *(const GAS f32x4*)(bs + DFF + c0), b1 = *(const GAS f32x4*)(bs + DFF + c0 + 4);
          yg[0] = a0.x; yg[1] = a0.y; yg[2] = a0.z; yg[3] = a0.w; yg[4] = a1.x; yg[5] = a1.y; yg[6] = a1.z; yg[7] = a1.w;
          yv[0] = b0.x; yv[1] = b0.y; yv[2] = b0.z; yv[3] = b0.w; yv[4] = b1.x; yv[5] = b1.y; yv[6] = b1.z; yv[7] = b1.w; }
#pragma unroll
        for (int k = 0; k < 3; ++k) {
            if (pos - 2 + k < 0) continue;
            const size_t row = (size_t)(t - 2 + k);
            const v4u ug = *(const GAS v4u*)(P.u + row * DFF2 + c0), uv = *(const GAS v4u*)(P.u + row * DFF2 + DFF + c0);
            const f32x4 g0 = *(const GAS f32x4*)(w + k * DFF2 + c0), g1 = *(const GAS f32x4*)(w + k * DFF2 + c0 + 4), v0 = *(const GAS f32x4*)(w + k * DFF2 + DFF + c0), v1 = *(const GAS f32x4*)(w + k * DFF2 + DFF + c0 + 4);
            yg[0] += g0.x * bflo(ug.x); yg[1] += g0.y * bfhi(ug.x); yg[2] += g0.z * bflo(ug.y); yg[3] += g0.w * bfhi(ug.y); yg[4] += g1.x * bflo(ug.z); yg[5] += g1.y * bfhi(ug.z); yg[6] += g1.z * bflo(ug.w); yg[7] += g1.w * bfhi(ug.w);
            yv[0] += v0.x * bflo(uv.x); yv[1] += v0.y * bfhi(uv.x); yv[2] += v0.z * bflo(uv.y); yv[3] += v0.w * bfhi(uv.y); yv[4] += v1.x * bflo(uv.z); yv[5] += v1.y * bfhi(uv.z); yv[6] += v1.z * bflo(uv.w); yv[7] += v1.w * bfhi(uv.w);
        }
        float hv[8];
#pragma unroll
        for (int e = 0; e < 8; ++e) hv[e] = (yg[e] / (1.f + expf(-yg[e]))) * yv[e];
        v4u o; o.x = pk2(hv[0], hv[1]); o.y = pk2(hv[2], hv[3]); o.z = pk2(hv[4], hv[5]); o.w = pk2(hv[6], hv[7]);
        *(GAS v4u*)(P.h + (size_t)t * DFF + c0) = o;
    }
}

constexpr int N_PHASES = 1 + 2 * 11 + 2 * 8;
struct Args { const float* in[19]; float* out; unsigned char* ws; int ph_lo, ph_hi, li, pad; };
__global__ void __launch_bounds__(NWAVES * 64, 2) trunk_fwd(Args args) {
    extern __shared__ __attribute__((aligned(16))) unsigned char lds_raw[];
    LAS unsigned char* lds = (LAS unsigned char*)lds_raw;
    volatile LAS unsigned* MISC = (volatile LAS unsigned*)(lds + MISC_OFF);
    const int G = gridDim.x, NT = G * NWAVES * 64, NGW = G * NWAVES;
    unsigned char* ws = args.ws;
    LAS unsigned long long* PT = (LAS unsigned long long*)(lds + PTAB_OFF);
    if (threadIdx.x == 0) {
        PT[0] = (unsigned long long)args.in[0]; PT[1] = (unsigned long long)args.in[1]; PT[2] = (unsigned long long)args.in[2]; PT[3] = (unsigned long long)args.in[3]; PT[4] = (unsigned long long)args.in[4];
        PT[5] = (unsigned long long)args.in[5]; PT[6] = (unsigned long long)args.in[6]; PT[7] = (unsigned long long)args.in[7]; PT[8] = (unsigned long long)args.in[8]; PT[9] = (unsigned long long)args.in[9];
        PT[10] = (unsigned long long)args.in[10]; PT[11] = (unsigned long long)args.in[11]; PT[12] = (unsigned long long)args.in[12]; PT[13] = (unsigned long long)args.in[13]; PT[14] = (unsigned long long)args.in[14];
        PT[15] = (unsigned long long)args.in[15]; PT[16] = (unsigned long long)args.in[16]; PT[17] = (unsigned long long)args.in[17]; PT[18] = (unsigned long long)args.in[18]; PT[19] = (unsigned long long)args.out;
    }
    if (threadIdx.x < 64) MISC[threadIdx.x] = 0u;
    __syncthreads();
    XcdBarrier bar; bar.bar = (unsigned*)(ws + WS_CTL) + CW_BAR; bar.x = 0; bar.st = nullptr;
#if ONE_LAUNCH
    bar = xcd_barrier_post((unsigned*)(ws + WS_CTL) + CW_BAR, MISC + 8);
#endif
    const int lo = args.ph_lo, hi = args.ph_hi;
    int p = 0;
#if ONE_LAUNCH
#define GRID_BAR() xcd_barrier(bar)
#else
#define GRID_BAR() do {} while (0)
#endif
#define RUN(...) do { if (p >= lo && p < hi) { int tid = threadIdx.x; asm volatile("" : "+v"(tid)); int bid = blockIdx.x; asm volatile("" : "+s"(bid)); \
        const int lane = tid & 63, wave = __builtin_amdgcn_readfirstlane(tid >> 6), gtid = bid * (NWAVES * 64) + tid, gw = bid * NWAVES + wave; (void)lane; (void)gtid; (void)gw; \
        Ptrs P; load_ptrs(P, PT, ws); __VA_ARGS__; if (p + 1 < hi) GRID_BAR(); } ++p; } while (0)

    RUN(ph_prologue(P, gtid, NT); ph_convert(P, 0, lds, gw, NGW, lane, gtid, NT));
    for (int l = 0; l < DEPTH; ++l) {
        const bool gla = (l & 1) == 0; const int j = l >> 1;
        RUN({ pg8::Gemm g{P.xn, P.win, M, gla ? LDP : CONV_IN, D}; pg8::StaticOrder S; S.init(M, gla ? LDP : CONV_IN, G, bid);
              pg8::EpiBf16 E{P.proj, LDP};
              if (!(SKIPMASK & 1024)) pg8::gemm_phase<pg8::EpiBf16, pg8::StaticOrder, true, true>(lds + RING_OFF, g, S, E, tid);
              pg8::Gemm g2{P.memb, P.wmkv, MM, 512, D}; pg8::StaticOrder S2; S2.init(MM, 512, G, bid);
              pg8::EpiBf16 E2{P.memkv, 512};
              if (!(SKIPMASK & 1024)) pg8::gemm_phase<pg8::EpiBf16, pg8::StaticOrder, true, true>(lds + RING_OFF, g2, S2, E2, tid); });
        RUN({ if (gla) ph_gla_g(P, j, gtid, NT); else ph_conv_mix(P, j, gtid, NT);
              ph_xattn(P, lds, tid, bid, G); });
        if (gla) {
            RUN(ph_gla_kv(P, lds, tid, bid, G));
            RUN(ph_gla_scan(P, gtid, NT));
            RUN(ph_gla_out(P, j, lds, tid, bid, G));
        }
        RUN({ pg8::Gemm g{P.abuf, P.wout, M, D, D}; pg8::StaticOrder S; S.init(M, D, G, bid);
              pg8::EpiResid E{P.xres, D, DN_ALPHA};
              if (!(SKIPMASK & 1024)) pg8::gemm_phase<pg8::EpiResid, pg8::StaticOrder, true, true>(lds + RING_OFF, g, S, E, tid); });
        RUN(ph_ln(P, P.ln1_g + (size_t)l * D, P.ln1_b + (size_t)l * D, gw, NGW, lane));
        RUN({ pg8::Gemm g{P.xn, P.wup, M, DFF2, D}; pg8::StaticOrder S; S.init(M, DFF2, G, bid);
              pg8::EpiBf16 E{P.u, DFF2};
              if (!(SKIPMASK & 1024)) pg8::gemm_phase<pg8::EpiBf16, pg8::StaticOrder, true, true>(lds + RING_OFF, g, S, E, tid); });
        RUN(ph_convgate(P, l, gtid, NT));
        RUN({ pg8::Gemm g{P.h, P.wdn, M, D, DFF}; pg8::StaticOrder S; S.init(M, D, G, bid);
              pg8::EpiResid E{P.xres, D, DN_ALPHA};
              if (!(SKIPMASK & 1024)) pg8::gemm_phase<pg8::EpiResid, pg8::StaticOrder, true, true>(lds + RING_OFF, g, S, E, tid); });
        RUN({ ph_ln(P, P.ln2_g + (size_t)l * D, P.ln2_b + (size_t)l * D, gw, NGW, lane);
              if (l + 1 < DEPTH) ph_convert(P, l + 1, lds, gw, NGW, lane, gtid, NT); });
    }
#undef RUN
}

extern "C" void kernel_launch(void* const* d_in, const int* in_sizes, int n_in, void* d_out, int out_size, void* d_ws, size_t ws_size, hipStream_t stream) {
    static int grid = 0;
    if (grid == 0) {
        if (n_in != 19 || out_size != M * D || ws_size < WS_END) { fprintf(stderr, "kernel_launch: unexpected shapes: n_in %d out %d ws %zu\n", n_in, out_size, ws_size); grid = -1; return; }
        int dev = 0, cus = 0, per_cu = 0;
        if (hipGetDevice(&dev) != hipSuccess || hipDeviceGetAttribute(&cus, hipDeviceAttributeMultiprocessorCount, dev) != hipSuccess) { grid = -1; return; }
        if (hipFuncSetAttribute((const void*)trunk_fwd, hipFuncAttributeMaxDynamicSharedMemorySize, LDS_BYTES) != hipSuccess) { fprintf(stderr, "kernel_launch: hipFuncSetAttribute failed\n"); grid = -1; return; }
        if (hipOccupancyMaxActiveBlocksPerMultiprocessor(&per_cu, (const void*)trunk_fwd, NWAVES * 64, LDS_BYTES) != hipSuccess || per_cu < 1) { fprintf(stderr, "kernel_launch: occupancy query says %d\n", per_cu); }
        (void)hipGetLastError();
        grid = cus;
    }
    if (grid < 0) return;
    if (hipMemsetAsync((char*)d_ws + WS_CTL, 0, CTL_ZERO_BYTES, stream) != hipSuccess) return;
    Args a{};
    for (int i = 0; i < 19; ++i) a.in[i] = (const float*)d_in[i];
    a.out = (float*)d_out; a.ws = (unsigned char*)d_ws;
#if ONE_LAUNCH
    a.ph_lo = 0; a.ph_hi = N_PHASES; a.li = 0;
    hipLaunchKernelGGL(trunk_fwd, dim3(grid), dim3(NWAVES * 64), LDS_BYTES, stream, a);
#else
    for (int p = 0; p < N_PHASES; ++p) { a.ph_lo = p; a.ph_hi = p + 1; a.li = p; hipLaunchKernelGGL(trunk_fwd, dim3(grid), dim3(NWAVES * 64), LDS_BYTES, stream, a); }
#endif
}
```

```cpp
#include <hip/hip_runtime.h>
#include <cstdio>
#include <cstdint>

#ifndef ONE_LAUNCH
#define ONE_LAUNCH 1
#endif

namespace pg8 {
#define PG8_LAS __attribute__((address_space(3)))
typedef unsigned short bf16_t;
typedef short bf16x8 __attribute__((ext_vector_type(8)));
typedef float f32x4 __attribute__((ext_vector_type(4)));
typedef unsigned u32x4 __attribute__((ext_vector_type(4)));
constexpr int BM = 256, BK = 64, HALF = 128, HTB = HALF * BK * 2  , STAGE_BYTES = 8 * HTB, NXCD = 8, WGM = 8;

__host__ __device__ __forceinline__ int lds_byte(int r, int c) { const int st = (r >> 4) * 2 + (c >> 5), rr = r & 15, cc = c & 31, ob = rr * 64 + cc * 2; return st * 1024 + (ob ^ (((ob >> 9) & 1) << 5)); }
__host__ __device__ __forceinline__ void stage_rc(int b, int& R, int& C) { const int st = b / 1024, sb = b % 1024, swz = sb ^ (((sb >> 9) & 1) << 5); R = (st >> 1) * 16 + swz / 64; C = (st & 1) * 32 + (swz % 64) / 2; }
__host__ __device__ __forceinline__ int perm32(int rho) { const int n = rho >> 4, i = rho & 15; return 8 * (i >> 2) + 4 * n + (i & 3); }

struct Unit { int pm, pn; };
struct Gemm { const bf16_t* A; const bf16_t* Bt; int M, N, K; };

struct StaticOrder {
    int nM, nN, nwg, G, c;
    __host__ __device__ void init(int M, int N, int G_, int c_) { nM = M / BM; nN = N / BM; nwg = nM * nN; G = G_; c = c_; }
    __host__ __device__ bool next(int i, Unit& u) const {
        const long L = (long)i * G + c; if (L >= nwg) return false;
        int wgid = (int)L; { const int q = nwg / NXCD, r = nwg % NXCD, xcd = wgid % NXCD, off = wgid / NXCD; wgid = (xcd < r ? xcd * (q + 1) : r * (q + 1) + (xcd - r) * q) + off; }
        const int nig = WGM * nN, gid = wgid / nig, fm = gid * WGM, gsz = (nM - fm) < WGM ? (nM - fm) : WGM;
        u.pm = fm + ((wgid % nig) % gsz); u.pn = (wgid % nig) / gsz; return true;
    }
    __device__ __forceinline__ void a_ready(const Unit&) const {}
    __device__ __forceinline__ void done(const Unit&) const {}
};


__device__ __forceinline__ unsigned cvt_pk_bf16(float lo, float hi) { unsigned r; asm volatile("v_cvt_pk_bf16_f32 %0, %1, %2" : "=v"(r) : "v"(lo), "v"(hi)); return r; }

struct EpiBf16 {
    static constexpr bool PERM = true, AFTER_DRAIN = false;
    bf16_t* O; int ldc;
    __device__ __forceinline__ void operator()(const f32x4 (&acc)[2][2][4][2], const Unit& u, int wr, int wc, int fr, int fq) const {
        const int row0 = u.pm * BM + wr * 64 + fr; const int col0 = u.pn * BM + wc * 32 + 8 * fq;
#pragma unroll
        for (int ai = 0; ai < 2; ++ai)
#pragma unroll
            for (int m = 0; m < 4; ++m) { bf16_t* rowp = O + (size_t)(row0 + ai * HALF + m * 16) * ldc + col0;
#pragma unroll
                for (int bj = 0; bj < 2; ++bj) { const f32x4 v0 = acc[ai][bj][m][0], v1 = acc[ai][bj][m][1];
                    u32x4 w; w.x = cvt_pk_bf16(v0[0], v0[1]); w.y = cvt_pk_bf16(v0[2], v0[3]); w.z = cvt_pk_bf16(v1[0], v1[1]); w.w = cvt_pk_bf16(v1[2], v1[3]);
                    *(u32x4*)(rowp + bj * HALF) = w; } }
    }
};
struct EpiResid {
    static constexpr bool PERM = false, AFTER_DRAIN = false;
    float* X; int ldc; float alpha;
    __device__ __forceinline__ void operator()(const f32x4 (&acc)[2][2][4][2], const Unit& u, int wr, int wc, int fr, int fq) const {
        const int row0 = u.pm * BM + wr * 64 + fr, col0 = u.pn * BM + wc * 32 + 4 * fq;
#pragma unroll
        for (int ai = 0; ai < 2; ++ai)
#pragma unroll
            for (int m = 0; m < 4; ++m) { float* rowp = X + (size_t)(row0 + ai * HALF + m * 16) * ldc + col0;
#pragma unroll
                for (int bj = 0; bj < 2; ++bj)
#pragma unroll
                    for (int n = 0; n < 2; ++n) { f32x4* p = (f32x4*)(rowp + bj * HALF + n * 16); const f32x4 o = *p; *p = o * alpha + acc[ai][bj][m][n]; } }
    }
};

template <class Epi, class Sched, bool ALIGN_EPI = false, bool SP2 = false>
__device__ __forceinline__ void gemm_phase(PG8_LAS unsigned char* lds, const Gemm g, const Sched& S, const Epi& E, const int tid) {
    const int wid = __builtin_amdgcn_readfirstlane(tid >> 6), lane = tid & 63, wr = wid >> 2, wc = wid & 3, fr = lane & 15, fq = lane >> 4;
    const int K = g.K, nt = K / BK;
    unsigned voffA[2], voffB[2];
#pragma unroll
    for (int i = 0; i < 2; ++i) { int R, C; stage_rc(tid * 16 + i * 8192, R, C); const int Rb = Epi::PERM ? ((R & ~31) + perm32(R & 31)) : R;
        voffA[i] = (unsigned)(R * K + C) * 2u; voffB[i] = (unsigned)(Rb * K + C) * 2u; }
    const size_t kstep = (size_t)(BK * 2);
    const size_t hstep = (size_t)HALF * K * 2;
    const size_t tstep = 2 * hstep;
    const unsigned ldsw = (unsigned)wid * 1024u;
    const int aoff = lds_byte(wr * 64 + fr, fq * 8), boff = lds_byte(wc * 32 + fr, fq * 8);
#define PG8_SA(b, h) (((b) * 2 + (h)) * HTB)
#define PG8_SB(b, h) ((4 + (b) * 2 + (h)) * HTB)
#define PG8_STAGE(bufoff, gbase, voff) do { _Pragma("unroll") for (int _i = 0; _i < 2; ++_i) \
        __builtin_amdgcn_global_load_lds((const unsigned*)((const char*)(gbase) + (voff)[_i]), (PG8_LAS unsigned*)(lds + (bufoff) + ldsw + _i * 8192), 16, 0, 0); } while (0)
#define PG8_LDA(dst, b, h) do { _Pragma("unroll") for (int m = 0; m < 4; ++m) _Pragma("unroll") for (int k = 0; k < 2; ++k) dst[m][k] = *(const PG8_LAS bf16x8*)(lds + PG8_SA(b, h) + aoff + m * 2048 + k * 1024); } while (0)
#define PG8_LDB(dst, b, h) do { _Pragma("unroll") for (int n = 0; n < 2; ++n) _Pragma("unroll") for (int k = 0; k < 2; ++k) dst[n][k] = *(const PG8_LAS bf16x8*)(lds + PG8_SB(b, h) + boff + n * 2048 + k * 1024); } while (0)
#define PG8_MMA(ai, bj, At, Bt) do { __builtin_amdgcn_s_setprio(1); _Pragma("unroll") for (int m = 0; m < 4; ++m) _Pragma("unroll") for (int n = 0; n < 2; ++n) _Pragma("unroll") for (int k = 0; k < 2; ++k) \
        acc[ai][bj][m][n] = __builtin_amdgcn_mfma_f32_16x16x32_bf16(Bt[n][k], At[m][k], acc[ai][bj][m][n], 0, 0, 0); __builtin_amdgcn_s_setprio(0); } while (0)
#define PG8_WAIT_V(n) asm volatile("s_waitcnt vmcnt(" #n ")" ::: "memory")
#define PG8_WAIT_L(n) asm volatile("s_waitcnt lgkmcnt(" #n ")" ::: "memory")
#define PG8_BAR __builtin_amdgcn_s_barrier()
#define PG8_SCHED __builtin_amdgcn_sched_barrier(0)
    Unit cur, nxt; int ui = 0;
    if (!S.next(0, cur)) return;
    f32x4 acc[2][2][4][2];
#pragma unroll
    for (int a = 0; a < 2; ++a)
#pragma unroll
        for (int b = 0; b < 2; ++b)
#pragma unroll
            for (int m = 0; m < 4; ++m)
#pragma unroll
                for (int n = 0; n < 2; ++n) acc[a][b][m][n] = (f32x4){0.f, 0.f, 0.f, 0.f};
    bf16x8 At[4][2], B0[2][2], B1[2][2];
    const char* cA = (const char*)g.A + (size_t)cur.pm * tstep; const char* cB = (const char*)g.Bt + (size_t)cur.pn * tstep;
    S.a_ready(cur);
    if constexpr (SP2) {
        PG8_STAGE(PG8_SB(0, 0), cB, voffB); PG8_STAGE(PG8_SB(0, 1), cB + hstep, voffB); PG8_STAGE(PG8_SA(0, 0), cA, voffA); PG8_STAGE(PG8_SA(0, 1), cA + hstep, voffA);
        if (wr == 1) PG8_BAR;
        PG8_WAIT_V(2); PG8_BAR;
        PG8_STAGE(PG8_SB(1, 0), cB + kstep, voffB); PG8_STAGE(PG8_SA(1, 0), cA + kstep, voffA); PG8_STAGE(PG8_SB(1, 1), cB + hstep + kstep, voffB);
        PG8_WAIT_V(6); PG8_BAR;
    } else {
        PG8_STAGE(PG8_SB(0, 0), cB, voffB); PG8_STAGE(PG8_SA(0, 0), cA, voffA); PG8_STAGE(PG8_SB(0, 1), cB + hstep, voffB); PG8_STAGE(PG8_SA(0, 1), cA + hstep, voffA);
        if (wr == 1) PG8_BAR;
        PG8_WAIT_V(4); PG8_BAR;
        PG8_STAGE(PG8_SB(1, 0), cB + kstep, voffB); PG8_STAGE(PG8_SA(1, 0), cA + kstep, voffA); PG8_STAGE(PG8_SB(1, 1), cB + hstep + kstep, voffB);
        PG8_WAIT_V(6); PG8_BAR;
    }
    for (;;) {
        const bool has_next = S.next(ui + 1, nxt);
        const char* nA = has_next ? (const char*)g.A + (size_t)nxt.pm * tstep : cA; const char* nB = has_next ? (const char*)g.Bt + (size_t)nxt.pn * tstep : cB;
        for (int t = 0; t < nt; t += 2) {
            const bool last = (t == nt - 2);
            const char* a1 = cA + (size_t)(t + 1) * kstep;
            const char* a2 = last ? nA : cA + (size_t)(t + 2) * kstep; const char* b2 = last ? nB : cB + (size_t)(t + 2) * kstep;
            const char* a3 = a2 + kstep; const char* b3 = b2 + kstep;
            if (last && has_next) S.a_ready(nxt);
            if constexpr (SP2) {
            PG8_LDB(B0, 0, 0); PG8_LDB(B1, 0, 1); PG8_SCHED; PG8_LDA(At, 0, 0); PG8_STAGE(PG8_SA(1, 1), a1 + hstep, voffA);
            PG8_WAIT_V(8); PG8_WAIT_L(0); PG8_BAR; PG8_MMA(0, 0, At, B0); PG8_MMA(0, 1, At, B1); PG8_BAR; PG8_SCHED;
            PG8_LDA(At, 0, 1); PG8_STAGE(PG8_SB(0, 0), b2, voffB); PG8_STAGE(PG8_SB(0, 1), b2 + hstep, voffB); PG8_STAGE(PG8_SA(0, 0), a2, voffA);
            PG8_WAIT_V(8); PG8_WAIT_L(0); PG8_BAR; PG8_MMA(1, 0, At, B0); PG8_MMA(1, 1, At, B1); PG8_BAR; PG8_SCHED;
            PG8_LDB(B0, 1, 0); PG8_LDB(B1, 1, 1); PG8_SCHED; PG8_LDA(At, 1, 0); PG8_STAGE(PG8_SA(0, 1), a2 + hstep, voffA);
            PG8_WAIT_V(8); PG8_WAIT_L(0); PG8_BAR; PG8_MMA(0, 0, At, B0); PG8_MMA(0, 1, At, B1); PG8_BAR; PG8_SCHED;
            PG8_LDA(At, 1, 1); PG8_STAGE(PG8_SB(1, 0), b3, voffB); PG8_STAGE(PG8_SB(1, 1), b3 + hstep, voffB); PG8_STAGE(PG8_SA(1, 0), a3, voffA);
            PG8_WAIT_V(8); PG8_WAIT_L(0); PG8_BAR; PG8_MMA(1, 0, At, B0); PG8_MMA(1, 1, At, B1); PG8_BAR; PG8_SCHED;
            } else {
            PG8_LDB(B0, 0, 0); PG8_SCHED; PG8_LDA(At, 0, 0); PG8_STAGE(PG8_SA(1, 1), a1 + hstep, voffA);
            PG8_WAIT_L(8); PG8_BAR; PG8_WAIT_L(0); PG8_MMA(0, 0, At, B0); PG8_BAR; PG8_SCHED;
            PG8_LDB(B1, 0, 1); PG8_STAGE(PG8_SB(0, 0), b2, voffB);
            PG8_BAR; PG8_WAIT_L(0); PG8_MMA(0, 1, At, B1); PG8_BAR;
            PG8_LDA(At, 0, 1); PG8_STAGE(PG8_SA(0, 0), a2, voffA);
            PG8_BAR; PG8_WAIT_L(0); PG8_MMA(1, 0, At, B0); PG8_BAR; PG8_SCHED;
            PG8_STAGE(PG8_SB(0, 1), b2 + hstep, voffB);
            PG8_WAIT_V(6); PG8_BAR; PG8_MMA(1, 1, At, B1); PG8_BAR;
            PG8_LDB(B0, 1, 0); PG8_SCHED; PG8_LDA(At, 1, 0); PG8_STAGE(PG8_SA(0, 1), a2 + hstep, voffA);
            PG8_WAIT_L(8); PG8_BAR; PG8_WAIT_L(0); PG8_MMA(0, 0, At, B0); PG8_BAR; PG8_SCHED;
            PG8_LDB(B1, 1, 1); PG8_STAGE(PG8_SB(1, 0), b3, voffB);
            PG8_BAR; PG8_WAIT_L(0); PG8_MMA(0, 1, At, B1); PG8_BAR;
            PG8_LDA(At, 1, 1); PG8_STAGE(PG8_SA(1, 0), a3, voffA);
            PG8_BAR; PG8_WAIT_L(0); PG8_MMA(1, 0, At, B0); PG8_BAR; PG8_SCHED;
            PG8_STAGE(PG8_SB(1, 1), b3 + hstep, voffB);
            PG8_WAIT_V(6); PG8_BAR; PG8_MMA(1, 1, At, B1); PG8_BAR;
            }
        }
        if constexpr (ALIGN_EPI) { if (wr == 0) PG8_BAR; }
        if constexpr (!Epi::AFTER_DRAIN) { E(acc, cur, wr, wc, fr, fq); S.done(cur); }
        if (!has_next) break;
#pragma unroll
        for (int a = 0; a < 2; ++a)
#pragma unroll
            for (int b = 0; b < 2; ++b)
#pragma unroll
                for (int m = 0; m < 4; ++m)
#pragma unroll
                    for (int n = 0; n < 2; ++n) acc[a][b][m][n] = (f32x4){0.f, 0.f, 0.f, 0.f};
        cur = nxt; cA = nA; cB = nB; ++ui;
        if constexpr (ALIGN_EPI) { if (wr == 1) PG8_BAR; }
    }
    PG8_WAIT_V(0);
    if constexpr (!ALIGN_EPI) { if (wr == 0) PG8_BAR; }
    PG8_BAR;
    if constexpr (Epi::AFTER_DRAIN) { E.fused(acc, cur, wr, wc, fr, fq, lds, wid, lane); S.done(cur); }
#undef PG8_SA
#undef PG8_SB
#undef PG8_STAGE
#undef PG8_LDA
#undef PG8_LDB
#undef PG8_MMA
#undef PG8_WAIT_V
#undef PG8_WAIT_L
#undef PG8_BAR
#undef PG8_SCHED
}
}

constexpr int NWAVES = 8;
constexpr int BATCH = 8, SEQ = 2048, D = 1024, DEPTH = 4;
constexpr int M = BATCH * SEQ;
constexpr int NMEM = 256, MM = BATCH * NMEM;
constexpr int XAW = 256, XAH = 4, XAD = 64, MIXW = 768;
constexpr int GH = 4, GDK = 384, GDV = 768, GHK = 96, GHV = 192, RANK = 16, CH = 64, NCH = SEQ / CH;
constexpr int DFF = 2816, DFF2 = 5632;
constexpr int GLA_IN = 2576, CONV_IN = 2560, LDP = 2816;
constexpr float LN_EPS = 1e-5f;
constexpr float DN_ALPHA = 1.6817928305074292f;
constexpr int PC_Q = 0, PC_K = 384, PC_V = 768, PC_R = 1536, PC_MQ = 2304, PC_GATE = 2560;
constexpr int PC_B = 0, PC_C = 768, PC_H = 1536;
constexpr int NUNITS_GLA = BATCH * GH * NCH;

constexpr size_t MiB = 1u << 20;
constexpr size_t WS_CTL = 0, CTL_ZERO_BYTES = 1 * MiB;
constexpr size_t WS_WIN = 1 * MiB;
constexpr size_t WS_WOUT = WS_WIN + 5 * MiB + MiB / 2;
constexpr size_t WS_WUP = WS_WOUT + 2 * MiB;
constexpr size_t WS_WDN = WS_WUP + 11 * MiB;
constexpr size_t WS_WMKV = WS_WDN + 5 * MiB + MiB / 2;
constexpr size_t WS_XN = 27 * MiB;
constexpr size_t WS_PROJ = 60 * MiB;
constexpr size_t WS_ABUF = 148 * MiB;
constexpr size_t WS_GB = 180 * MiB;
constexpr size_t WS_MEMKV = 204 * MiB;
constexpr size_t WS_U = 60 * MiB;
constexpr size_t WS_H = 236 * MiB;
constexpr size_t WS_ST = 236 * MiB;
constexpr size_t WS_DEC = 308 * MiB;
constexpr size_t WS_MEMB = 324 * MiB;
constexpr size_t WS_END = 328 * MiB;
static_assert(WS_WMKV + 1 * MiB <= WS_XN && WS_U + (size_t)M * DFF2 * 2 <= WS_H && WS_DEC + (size_t)NUNITS_GLA * GHK * 4 <= WS_MEMB, "d_ws map");
constexpr int CW_BAR = 4096;

constexpr int LDS_BYTES = 163840;
constexpr int RING_OFF = 0;
constexpr int MISC_OFF = 163840 - 256;
constexpr int PTAB_OFF = 163840 - 512;

#define GAS __attribute__((address_space(1)))
#define LAS __attribute__((address_space(3)))
typedef unsigned short bf16;
typedef unsigned v4u __attribute__((ext_vector_type(4)));
typedef unsigned v2u __attribute__((ext_vector_type(2)));
typedef float f32x4 __attribute__((ext_vector_type(4)));
typedef GAS unsigned gu32;
#define RLX_AGENT __ATOMIC_RELAXED, __HIP_MEMORY_SCOPE_AGENT
#define LDS_WAIT() asm volatile("s_waitcnt lgkmcnt(0)" ::: "memory")
__device__ __forceinline__ unsigned f2bf(float f) { unsigned u = __builtin_bit_cast(unsigned, f); return (u + 0x7fffu + ((u >> 16) & 1u)) >> 16; }
__device__ __forceinline__ unsigned pk2(float lo, float hi) { return f2bf(lo) | (f2bf(hi) << 16); }
__device__ __forceinline__ float bf2f(unsigned short b) { return __uint_as_float(((unsigned)b) << 16); }
__device__ __forceinline__ float bflo(unsigned w) { return __uint_as_float(w << 16); }
__device__ __forceinline__ float bfhi(unsigned w) { return __uint_as_float(w & 0xffff0000u); }
__device__ __forceinline__ float wave_sum(float v) {
#pragma unroll
    for (int o = 1; o < 64; o <<= 1) v += __shfl_xor(v, o);
    return v;
}
__device__ __forceinline__ float wave_max(float v) {
#pragma unroll
    for (int o = 1; o < 64; o <<= 1) v = fmaxf(v, __shfl_xor(v, o));
    return v;
}
#define XB_TMO      128
#define XB_XCNT(j)  (256  + 64 * (j))
#define XB_XSUB(j)  (1280 + 64 * (j))
#define XB_XGEN(j)  (2304 + 64 * (j))
#define XB_TOP      3328
#define XB_TOPGEN   3392
#define XCD_BAR_WORDS 3456
#define XB_SPIN_CAP (1u << 18)

__device__ __forceinline__ unsigned xb_ld(unsigned* p)              { return __hip_atomic_load(p, __ATOMIC_RELAXED, __HIP_MEMORY_SCOPE_AGENT); }
__device__ __forceinline__ unsigned xb_add(unsigned* p, unsigned v) { return __hip_atomic_fetch_add(p, v, __ATOMIC_RELAXED, __HIP_MEMORY_SCOPE_AGENT); }
__device__ __forceinline__ unsigned xb_xcc_id() { return (unsigned)__builtin_amdgcn_s_getreg((3 << 11) | 20) & 0xFu; }
#define XB_SPIN(cond, bar) do { unsigned _sp = 0; while (cond) { __builtin_amdgcn_s_sleep(1); \
    if ((++_sp & 255u) == 0u) { if (xb_ld(&(bar)[XB_TMO])) break; if (_sp > XB_SPIN_CAP) { atomicAdd(&(bar)[XB_TMO], 1u); break; } } } } while (0)

struct XcdBarrier {
    unsigned* bar; unsigned x;
    volatile LAS unsigned* st;
};

__device__ __forceinline__ XcdBarrier xcd_barrier_post(unsigned* bar, volatile LAS unsigned* st) {
    XcdBarrier b; b.bar = bar; b.x = xb_xcc_id(); b.st = st;
    if (threadIdx.x == 0) (void)xb_add(&bar[XB_XCNT(b.x)], 1u);
    return b;
}
__device__ __forceinline__ void xcd_barrier_complete(unsigned* bar, unsigned x, unsigned& nloc, unsigned& nx) {
    const unsigned G = gridDim.x * gridDim.y * gridDim.z;
    unsigned sum, cnt, mine, sp = 0u;
    for (;;) {
        sum = 0u; cnt = 0u; mine = 0u;
#pragma unroll
        for (unsigned j = 0; j < 16; ++j) { const unsigned c = xb_ld(&bar[XB_XCNT(j)]); sum += c; cnt += (c > 0u) ? 1u : 0u; mine = (j == x) ? c : mine; }
        if (sum == G) break;
        __builtin_amdgcn_s_sleep(1);
        if ((++sp & 255u) == 0u) { if (xb_ld(&bar[XB_TMO])) break; if (sp > XB_SPIN_CAP) { atomicAdd(&bar[XB_TMO], 1u); break; } }
    }
    nloc = mine > 0u ? mine : 1u; nx = cnt > 0u ? cnt : 1u;
}

__device__ __forceinline__ void xcd_barrier(const XcdBarrier& b) {
    asm volatile("s_waitcnt vmcnt(0)" ::: "memory");
    __syncthreads();
    if (threadIdx.x == 0) {
        unsigned* bar = b.bar;
        __builtin_amdgcn_s_waitcnt(0);
        unsigned nloc = b.st[0], nx = b.st[1];
        if (nloc == 0u) { xcd_barrier_complete(bar, b.x, nloc, nx); b.st[0] = nloc; b.st[1] = nx; }
        const unsigned old = xb_add(&bar[XB_XSUB(b.x)], 1u);
        const unsigned gen = old / nloc;
        if (old + 1u == (gen + 1u) * nloc) {
            __builtin_amdgcn_fence(__ATOMIC_RELEASE, "agent");
            asm volatile("s_waitcnt vmcnt(0)" ::: "memory");
            const unsigned og = xb_add(&bar[XB_TOP], 1u);
            const unsigned tg = og / nx;
            if (og + 1u == (tg + 1u) * nx) xb_add(&bar[XB_TOPGEN], 1u);
            else XB_SPIN(xb_ld(&bar[XB_TOPGEN]) == tg, bar);
            __builtin_amdgcn_fence(__ATOMIC_ACQUIRE, "agent");
            xb_add(&bar[XB_XGEN(b.x)], 1u);
            asm volatile("s_waitcnt vmcnt(0)" ::: "memory");
        } else {
            XB_SPIN(xb_ld(&bar[XB_XGEN(b.x)]) == gen, bar);
            __builtin_amdgcn_fence(__ATOMIC_ACQUIRE, "agent");
            asm volatile("s_waitcnt vmcnt(0)" ::: "memory");
        }
    }
    __syncthreads();
}

#ifndef SKIPMASK
#define SKIPMASK 0
#endif
#ifndef XATTN_MFMA
#define XATTN_MFMA 1
#endif
#ifndef REPMASK
#define REPMASK 0
#endif
#define REP(bit) for (int rep_ = 0; rep_ < ((REPMASK & (bit)) ? 2 : 1); ++rep_)
__device__ __forceinline__ int dest_row(int mode, int n) {
    if (mode == 1) return n < 2304 ? n : (n < 2320 ? n + 256 : n - 16);
    return n;
}
__device__ __forceinline__ void transpose_item(const float* W, int K, int N, bf16* WT, int mode, LAS float* scr, int item, int lane) {
    const int nblk = (N + 31) / 32, kb = item / nblk, nb = item % nblk, k0 = 64 * kb, n0 = 32 * nb;
    const int nn = n0 + (lane & 31);
#pragma unroll 8
    for (int i = 0; i < 32; ++i) { const int kk = 2 * i + (lane >> 5); scr[kk * 33 + (lane & 31)] = (nn < N) ? W[(size_t)(k0 + kk) * N + nn] : 0.f; }
    LDS_WAIT(); asm volatile("" ::: "memory");
    const int c = lane & 7;
#pragma unroll
    for (int j = 0; j < 4; ++j) { const int n = (lane >> 3) + 8 * j; const LAS float* s = scr + (8 * c) * 33 + n;
        v4u o; o.x = pk2(s[0 * 33], s[1 * 33]); o.y = pk2(s[2 * 33], s[3 * 33]); o.z = pk2(s[4 * 33], s[5 * 33]); o.w = pk2(s[6 * 33], s[7 * 33]);
        if (n0 + n < N) *(GAS v4u*)(WT + (size_t)dest_row(mode, n0 + n) * K + k0 + 8 * c) = o; }
    LDS_WAIT(); asm volatile("" ::: "memory");
}

struct Ptrs {
    const float *x, *mem, *gla_w_in, *gla_w_a2, *gla_b_a, *gla_head_g, *gla_w_out, *conv_w_in, *conv_w, *conv_w_out, *w_mem_kv, *ln1_g, *ln1_b, *ffn_w_up, *ffn_conv_w, *ffn_conv_b, *ffn_w_down, *ln2_g, *ln2_b;
    float* xres;
    bf16 *win, *wout, *wup, *wdn, *wmkv, *xn, *proj, *abuf, *memkv, *u, *h, *memb;
    float *gb, *st, *dec;
};
__device__ __forceinline__ const float* gp(const LAS unsigned long long* PT, int k) {
    const unsigned long long v = PT[k];
    const unsigned lo = __builtin_amdgcn_readfirstlane((unsigned)v), hi = __builtin_amdgcn_readfirstlane((unsigned)(v >> 32));
    return (const float*)(const GAS float*)(((unsigned long long)hi << 32) | lo);
}
__device__ __forceinline__ void load_ptrs(Ptrs& P, const LAS unsigned long long* PT, unsigned char* ws_) {
    asm volatile("" ::: "memory");
    unsigned char* ws = (unsigned char*)(GAS unsigned char*)ws_;
    P.x = gp(PT, 0); P.mem = gp(PT, 1); P.gla_w_in = gp(PT, 2); P.gla_w_a2 = gp(PT, 3); P.gla_b_a = gp(PT, 4); P.gla_head_g = gp(PT, 5); P.gla_w_out = gp(PT, 6);
    P.conv_w_in = gp(PT, 7); P.conv_w = gp(PT, 8); P.conv_w_out = gp(PT, 9); P.w_mem_kv = gp(PT, 10); P.ln1_g = gp(PT, 11); P.ln1_b = gp(PT, 12);
    P.ffn_w_up = gp(PT, 13); P.ffn_conv_w = gp(PT, 14); P.ffn_conv_b = gp(PT, 15); P.ffn_w_down = gp(PT, 16); P.ln2_g = gp(PT, 17); P.ln2_b = gp(PT, 18);
    P.xres = (float*)gp(PT, 19);
    P.win = (bf16*)(ws + WS_WIN); P.wout = (bf16*)(ws + WS_WOUT); P.wup = (bf16*)(ws + WS_WUP); P.wdn = (bf16*)(ws + WS_WDN); P.wmkv = (bf16*)(ws + WS_WMKV);
    P.xn = (bf16*)(ws + WS_XN); P.proj = (bf16*)(ws + WS_PROJ); P.abuf = (bf16*)(ws + WS_ABUF); P.memkv = (bf16*)(ws + WS_MEMKV); P.u = (bf16*)(ws + WS_U); P.h = (bf16*)(ws + WS_H); P.memb = (bf16*)(ws + WS_MEMB);
    P.gb = (float*)(ws + WS_GB); P.st = (float*)(ws + WS_ST); P.dec = (float*)(ws + WS_DEC);
}

__device__ __forceinline__ void ph_convert(const Ptrs& P, int l, LAS unsigned char* lds, int gw, int NGW, int lane, int gtid, int NT) {
    if (SKIPMASK & 2) return;
    LAS float* scr = (LAS float*)(lds + (gw % NWAVES) * 16384);
    const bool gla = (l & 1) == 0; const int j = l >> 1;
    const float* Win = gla ? P.gla_w_in + (size_t)j * D * GLA_IN : P.conv_w_in + (size_t)j * D * CONV_IN; const int Nin = gla ? GLA_IN : CONV_IN;
    const float* Wout = gla ? P.gla_w_out + (size_t)j * D * D : P.conv_w_out + (size_t)j * D * D;
    const float* Wup = P.ffn_w_up + (size_t)l * D * DFF2; const float* Wdn = P.ffn_w_down + (size_t)l * DFF * D; const float* Wmkv = P.w_mem_kv + (size_t)l * D * 512;
    const int I_IN = (D / 64) * ((Nin + 31) / 32), I_OUT = (D / 64) * (D / 32), I_UP = (D / 64) * (DFF2 / 32), I_DN = (DFF / 64) * (D / 32), I_MKV = (D / 64) * (512 / 32);
    const int total = I_IN + I_OUT + I_UP + I_DN + I_MKV;
    for (int it = gw; it < total; it += NGW) {
        int r = it;
        if (r < I_IN) { transpose_item(Win, D, Nin, P.win, gla ? 1 : 0, scr, r, lane); continue; } r -= I_IN;
        if (r < I_OUT) { transpose_item(Wout, D, D, P.wout, 0, scr, r, lane); continue; } r -= I_OUT;
        if (r < I_UP) { transpose_item(Wup, D, DFF2, P.wup, 0, scr, r, lane); continue; } r -= I_UP;
        if (r < I_DN) { transpose_item(Wdn, DFF, D, P.wdn, 0, scr, r, lane); continue; } r -= I_DN;
        transpose_item(Wmkv, D, 512, P.wmkv, 0, scr, r, lane);
    }
    if (gla) { GAS v4u* z = (GAS v4u*)(P.win + (size_t)GLA_IN * D); for (int i = gtid; i < (LDP - GLA_IN) * D * 2 / 16; i += NT) z[i] = (v4u){0u, 0u, 0u, 0u}; }
}

__device__ __forceinline__ void ph_prologue(const Ptrs& P, int gtid, int NT) {
    if (SKIPMASK & 1) return;
    for (int i = gtid; i < M * D / 4; i += NT) { const f32x4 v = ((const GAS f32x4*)P.x)[i]; ((GAS f32x4*)P.xres)[i] = v; v2u w; w.x = pk2(v.x, v.y); w.y = pk2(v.z, v.w); ((GAS v2u*)P.xn)[i] = w; }
    for (int i = gtid; i < MM * D / 4; i += NT) { const f32x4 v = ((const GAS f32x4*)P.mem)[i]; v2u w; w.x = pk2(v.x, v.y); w.y = pk2(v.z, v.w); ((GAS v2u*)P.memb)[i] = w; }
}

__device__ __forceinline__ void ph_ln(const Ptrs& P, const float* g, const float* b, int gw, int NGW, int lane) {
    if (SKIPMASK & 4) return;
    for (int m = gw; m < M; m += NGW) {
        GAS f32x4* xr = (GAS f32x4*)(P.xres + (size_t)m * D) + lane;
        f32x4 v[4]; float s = 0.f;
#pragma unroll
        for (int j = 0; j < 4; ++j) { v[j] = xr[64 * j]; s += (v[j].x + v[j].y) + (v[j].z + v[j].w); }
        const float mean = wave_sum(s) * (1.f / D); float s2 = 0.f;
#pragma unroll
        for (int j = 0; j < 4; ++j) { v[j] = v[j] - mean; s2 += (v[j].x * v[j].x + v[j].y * v[j].y) + (v[j].z * v[j].z + v[j].w * v[j].w); }
        const float rstd = 1.f / sqrtf(wave_sum(s2) * (1.f / D) + LN_EPS);
        GAS v2u* o8 = (GAS v2u*)(P.xn + (size_t)m * D) + lane;
#pragma unroll
        for (int j = 0; j < 4; ++j) { const f32x4 gg = ((const GAS f32x4*)g)[lane + 64 * j], bb = ((const GAS f32x4*)b)[lane + 64 * j];
            const f32x4 o = v[j] * rstd * gg + bb; xr[64 * j] = o; v2u w; w.x = pk2(o.x, o.y); w.y = pk2(o.z, o.w); o8[64 * j] = w; }
    }
}

__device__ __forceinline__ void ph_gla_g(const Ptrs& P, int j, int gtid, int NT) {
    if (SKIPMASK & 8) return;
    for (int idx = gtid; idx < (M / CH) * GDK; idx += NT) {
        const int c = idx % GDK, t0 = (idx / GDK) * CH;
        float w[RANK];
#pragma unroll
        for (int r = 0; r < RANK; ++r) w[r] = P.gla_w_a2[((size_t)j * RANK + r) * GDK + c];
        const float bias = P.gla_b_a[(size_t)j * GDK + c];
        float G = 0.f;
        for (int t = 0; t < CH; ++t) {
            const GAS v4u* gp = (const GAS v4u*)(P.proj + (size_t)(t0 + t) * LDP + PC_GATE);
            const v4u g0 = gp[0], g1 = gp[1];
            float z = bias;
            z += bflo(g0.x) * w[0] + bfhi(g0.x) * w[1] + bflo(g0.y) * w[2] + bfhi(g0.y) * w[3] + bflo(g0.z) * w[4] + bfhi(g0.z) * w[5] + bflo(g0.w) * w[6] + bfhi(g0.w) * w[7];
            z += bflo(g1.x) * w[8] + bfhi(g1.x) * w[9] + bflo(g1.y) * w[10] + bfhi(g1.y) * w[11] + bflo(g1.z) * w[12] + bfhi(g1.z) * w[13] + bflo(g1.w) * w[14] + bfhi(g1.w) * w[15];
            const float ls = fminf(z, 0.f) - log1pf(expf(-fabsf(z)));
            G += ls * (1.0f / 16.0f);
            P.gb[(size_t)(t0 + t) * GDK + c] = G;
        }
    }
}

__device__ __forceinline__ void ph_gla_kv(const Ptrs& P, LAS unsigned char* lds, int tid, int bid, int G) {
    if (SKIPMASK & 16) return;
    LAS float* KE = (LAS float*)lds;
    LAS float* VL = (LAS float*)(lds + 64 * 96 * 4);
    for (int u = bid; u < NUNITS_GLA; u += G) {
        const int b = u / (GH * NCH), h = (u / NCH) % GH, n = u % NCH, t0 = b * SEQ + n * CH;
        for (int e = tid; e < CH * GHK; e += 512) { const int t = e / GHK, i = e % GHK;
            const float g = P.gb[(size_t)(t0 + t) * GDK + h * GHK + i], gl = P.gb[(size_t)(t0 + CH - 1) * GDK + h * GHK + i];
            KE[e] = bf2f(P.proj[(size_t)(t0 + t) * LDP + PC_K + h * GHK + i]) * expf(gl - g); }
        for (int e = tid; e < CH * GHV; e += 512) { const int t = e / GHV, v = e % GHV; VL[e] = bf2f(P.proj[(size_t)(t0 + t) * LDP + PC_V + h * GHV + v]); }
        if (tid < GHK) P.dec[(size_t)u * GHK + tid] = expf(P.gb[(size_t)(t0 + CH - 1) * GDK + h * GHK + tid]);
        __syncthreads();
        const int vb = tid & 31, ib = tid >> 5;
        float acc[6][6];
#pragma unroll
        for (int a = 0; a < 6; ++a)
#pragma unroll
            for (int c = 0; c < 6; ++c) acc[a][c] = 0.f;
        for (int t = 0; t < CH; ++t) {
            float vv[6], kk[6];
#pragma unroll
            for (int a = 0; a < 6; ++a) vv[a] = VL[t * GHV + vb + 32 * a];
#pragma unroll
            for (int c = 0; c < 6; ++c) kk[c] = KE[t * GHK + ib * 6 + c];
#pragma unroll
            for (int a = 0; a < 6; ++a)
#pragma unroll
                for (int c = 0; c < 6; ++c) acc[a][c] += vv[a] * kk[c];
        }
        float* so = P.st + (size_t)u * (GHV * GHK);
#pragma unroll
        for (int a = 0; a < 6; ++a)
#pragma unroll
            for (int c = 0; c < 6; ++c) so[(vb + 32 * a) * GHK + ib * 6 + c] = acc[a][c];
        __syncthreads();
    }
}

__device__ __forceinline__ void ph_gla_scan(const Ptrs& P, int gtid, int NT) {
    if (SKIPMASK & 32) return;
    constexpr int E = GHV * GHK;
    for (int idx = gtid; idx < BATCH * GH * E; idx += NT) {
        const int e = idx % E, bh = idx / E, i = e % GHK;
        float S = 0.f;
        for (int n = 0; n < NCH; ++n) { const size_t off = (size_t)(bh * NCH + n) * E + e; const float kvv = P.st[off]; P.st[off] = S; S = P.dec[(size_t)(bh * NCH + n) * GHK + i] * S + kvv; }
    }
}

__device__ __forceinline__ void ph_gla_out(const Ptrs& P, int j, LAS unsigned char* lds, int tid, int bid, int G) {
    if (SKIPMASK & 64) return;
    LAS float* QD = (LAS float*)lds;
    LAS float* KI = (LAS float*)(lds + 64 * 97 * 4);
    LAS float* AT = (LAS float*)(lds + 2 * 64 * 97 * 4);
    LAS float* VL = (LAS float*)(lds + 2 * 64 * 97 * 4 + 64 * 65 * 4);
    const int lane = tid & 63, wave = tid >> 6;
    const float scale = 0.10206207261596577f;
    for (int u = bid; u < NUNITS_GLA; u += G) {
        const int b = u / (GH * NCH), h = (u / NCH) % GH, n = u % NCH, t0 = b * SEQ + n * CH;
        for (int e = tid; e < CH * GHK; e += 512) { const int t = e / GHK, i = e % GHK;
            const float g = P.gb[(size_t)(t0 + t) * GDK + h * GHK + i];
            const float q = bf2f(P.proj[(size_t)(t0 + t) * LDP + PC_Q + h * GHK + i]), k = bf2f(P.proj[(size_t)(t0 + t) * LDP + PC_K + h * GHK + i]);
            QD[t * 97 + i] = q * scale * expf(g); KI[t * 97 + i] = k * expf(-g); }
        for (int e = tid; e < CH * GHV; e += 512) { const int t = e / GHV, v = e % GHV; VL[e] = bf2f(P.proj[(size_t)(t0 + t) * LDP + PC_V + h * GHV + v]); }
        __syncthreads();
        {
            float a[8];
#pragma unroll
            for (int r = 0; r < 8; ++r) a[r] = 0.f;
            for (int k = 0; k < GHK; ++k) { const float kv = KI[lane * 97 + k];
#pragma unroll
                for (int r = 0; r < 8; ++r) a[r] += QD[(wave * 8 + r) * 97 + k] * kv; }
#pragma unroll
            for (int r = 0; r < 8; ++r) AT[(wave * 8 + r) * 65 + lane] = (lane <= wave * 8 + r) ? a[r] : 0.f;
        }
        __syncthreads();
        float o[8][3];
#pragma unroll
        for (int r = 0; r < 8; ++r)
#pragma unroll
            for (int a = 0; a < 3; ++a) o[r][a] = 0.f;
        for (int jj = 0; jj < CH; ++jj) { float vv[3];
#pragma unroll
            for (int a = 0; a < 3; ++a) vv[a] = VL[jj * GHV + lane + 64 * a];
#pragma unroll
            for (int r = 0; r < 8; ++r) { const float at = AT[(wave * 8 + r) * 65 + jj];
#pragma unroll
                for (int a = 0; a < 3; ++a) o[r][a] += at * vv[a]; } }
        const float* sp = P.st + (size_t)u * (GHV * GHK);
        for (int k = 0; k < GHK; k += 4) { f32x4 sv[3];
#pragma unroll
            for (int a = 0; a < 3; ++a) sv[a] = *(const GAS f32x4*)(sp + (size_t)(lane + 64 * a) * GHK + k);
#pragma unroll
            for (int r = 0; r < 8; ++r) { const float q0 = QD[(wave * 8 + r) * 97 + k], q1 = QD[(wave * 8 + r) * 97 + k + 1], q2 = QD[(wave * 8 + r) * 97 + k + 2], q3 = QD[(wave * 8 + r) * 97 + k + 3];
#pragma unroll
                for (int a = 0; a < 3; ++a) o[r][a] += q0 * sv[a].x + q1 * sv[a].y + q2 * sv[a].z + q3 * sv[a].w; } }
#pragma unroll
        for (int r = 0; r < 8; ++r) {
            const float ss = wave_sum(o[r][0] * o[r][0] + o[r][1] * o[r][1] + o[r][2] * o[r][2]);
            const float rs = 1.f / sqrtf(ss * (1.f / GHV) + LN_EPS);
            const size_t row = (size_t)(t0 + wave * 8 + r);
#pragma unroll
            for (int a = 0; a < 3; ++a) { const int col = h * GHV + lane + 64 * a;
                const float rr = bf2f(P.proj[row * LDP + PC_R + col]);
                const float val = o[r][a] * rs * P.gla_head_g[(size_t)j * GDV + col] * (rr / (1.f + expf(-rr)));
                P.abuf[row * D + col] = (bf16)f2bf(val); }
        }
        __syncthreads();
    }
}

__device__ __forceinline__ void ph_conv_mix(const Ptrs& P, int j, int gtid, int NT) {
    if (SKIPMASK & 128) return;
    const float* w = P.conv_w + (size_t)j * 3 * MIXW;
    for (int idx = gtid; idx < M * (MIXW / 8); idx += NT) {
        const int cg = idx % (MIXW / 8), t = idx / (MIXW / 8), c0 = cg * 8, pos = t % SEQ;
        float y[8];
#pragma unroll
        for (int e = 0; e < 8; ++e) y[e] = 0.f;
#pragma unroll
        for (int k = 0; k < 3; ++k) {
            if (pos - 2 + k < 0) continue;
            const size_t row = (size_t)(t - 2 + k);
            const v4u cc = *(const GAS v4u*)(P.proj + row * LDP + PC_C + c0), hh = *(const GAS v4u*)(P.proj + row * LDP + PC_H + c0);
            const f32x4 w0 = *(const GAS f32x4*)(w + k * MIXW + c0), w1 = *(const GAS f32x4*)(w + k * MIXW + c0 + 4);
            y[0] += w0.x * (bflo(cc.x) * bflo(hh.x)); y[1] += w0.y * (bfhi(cc.x) * bfhi(hh.x)); y[2] += w0.z * (bflo(cc.y) * bflo(hh.y)); y[3] += w0.w * (bfhi(cc.y) * bfhi(hh.y));
            y[4] += w1.x * (bflo(cc.z) * bflo(hh.z)); y[5] += w1.y * (bfhi(cc.z) * bfhi(hh.z)); y[6] += w1.z * (bflo(cc.w) * bflo(hh.w)); y[7] += w1.w * (bfhi(cc.w) * bfhi(hh.w));
        }
        const v4u bb = *(const GAS v4u*)(P.proj + (size_t)t * LDP + PC_B + c0);
        v4u o; o.x = pk2(bflo(bb.x) * y[0], bfhi(bb.x) * y[1]); o.y = pk2(bflo(bb.y) * y[2], bfhi(bb.y) * y[3]); o.z = pk2(bflo(bb.z) * y[4], bfhi(bb.z) * y[5]); o.w = pk2(bflo(bb.w) * y[6], bfhi(bb.w) * y[7]);
        *(GAS v4u*)(P.abuf + (size_t)t * D + c0) = o;
    }
}

__device__ __forceinline__ void ph_xattn(const Ptrs& P, LAS unsigned char* lds, int tid, int bid, int G) {
    if (SKIPMASK & 256) return;
    LAS float* KL = (LAS float*)lds;
    LAS float* VL = (LAS float*)(lds + 256 * 65 * 4);
    LAS float* PL = (LAS float*)(lds + 256 * 65 * 4 + 256 * 64 * 4);
    LAS float* QL = (LAS float*)(lds + 256 * 65 * 4 + 256 * 64 * 4 + 8 * 256 * 4);
    const int lane = tid & 63, wave = tid >> 6;
    for (int u = bid; u < BATCH * XAH * (SEQ / 256); u += G) {
        const int b = u / (XAH * (SEQ / 256)), h = (u / (SEQ / 256)) % XAH, tb = u % (SEQ / 256);
        for (int e = tid; e < NMEM * XAD; e += 512) { const int m = e / XAD, d = e % XAD; const size_t r = (size_t)(b * NMEM + m) * 512;
            KL[m * 65 + d] = bf2f(P.memkv[r + h * XAD + d]); VL[m * 64 + d] = bf2f(P.memkv[r + 256 + h * XAD + d]); }
        __syncthreads();
        for (int tt = 0; tt < 32; ++tt) {
            const size_t t = (size_t)b * SEQ + tb * 256 + wave * 32 + tt;
            QL[wave * 64 + lane] = bf2f(P.proj[t * LDP + PC_MQ + h * XAD + lane]);
            LDS_WAIT(); asm volatile("" ::: "memory");
            float s[4] = {0.f, 0.f, 0.f, 0.f};
            for (int d = 0; d < XAD; ++d) { const float q = QL[wave * 64 + d];
#pragma unroll
                for (int c = 0; c < 4; ++c) s[c] += q * KL[(lane + 64 * c) * 65 + d]; }
#pragma unroll
            for (int c = 0; c < 4; ++c) s[c] *= 0.125f;
            const float mx = wave_max(fmaxf(fmaxf(s[0], s[1]), fmaxf(s[2], s[3])));
            float p[4], ps = 0.f;
#pragma unroll
            for (int c = 0; c < 4; ++c) { p[c] = expf(s[c] - mx); ps += p[c]; PL[wave * 256 + lane + 64 * c] = p[c]; }
            ps = wave_sum(ps);
            LDS_WAIT(); asm volatile("" ::: "memory");
            float o = 0.f;
            for (int m = 0; m < NMEM; ++m) o += PL[wave * 256 + m] * VL[m * 64 + lane];
            P.abuf[t * D + MIXW + h * XAD + lane] = (bf16)f2bf(o / ps);
            LDS_WAIT(); asm volatile("" ::: "memory");
        }
        __syncthreads();
    }
}


typedef short bf16x8v __attribute__((ext_vector_type(8)));
__device__ __forceinline__ unsigned cvtpk(float lo, float hi) { unsigned r; asm volatile("v_cvt_pk_bf16_f32 %0, %1, %2" : "=v"(r) : "v"(lo), "v"(hi)); return r; }
__device__ __forceinline__ void ph_xattn_mfma(const Ptrs& P, LAS unsigned char* lds, int tid, int bid, int G) {
    constexpr int KST = 144, VST = 528;
    LAS unsigned char* KL = lds;
    LAS unsigned char* VL = lds + 256 * KST;
    const int lane = tid & 63, wave = tid >> 6, fr = lane & 15, fq = lane >> 4;
    for (int u = bid; u < BATCH * XAH * (SEQ / 256); u += G) {
        const int b = u / (XAH * (SEQ / 256)), h = (u / (SEQ / 256)) % XAH, tb = u % (SEQ / 256);
        for (int e = tid; e < NMEM * 8; e += 512) { const int m = e >> 3, c = e & 7; const bf16* src = P.memkv + (size_t)(b * NMEM + m) * 512 + h * XAD + c * 8;
            const v4u kv = *(const GAS v4u*)src, vv = *(const GAS v4u*)(src + 256);
            *(LAS v4u*)(KL + m * KST + c * 16) = kv;
            const int slot = (m & ~31) + 8 * ((m >> 2) & 3) + 4 * ((m >> 4) & 1) + (m & 3);
            LAS unsigned short* vd = (LAS unsigned short*)(VL + (c * 8) * VST + slot * 2);
            vd[0 * (VST / 2)] = (unsigned short)(vv.x & 0xffffu); vd[1 * (VST / 2)] = (unsigned short)(vv.x >> 16); vd[2 * (VST / 2)] = (unsigned short)(vv.y & 0xffffu); vd[3 * (VST / 2)] = (unsigned short)(vv.y >> 16);
            vd[4 * (VST / 2)] = (unsigned short)(vv.z & 0xffffu); vd[5 * (VST / 2)] = (unsigned short)(vv.z >> 16); vd[6 * (VST / 2)] = (unsigned short)(vv.w & 0xffffu); vd[7 * (VST / 2)] = (unsigned short)(vv.w >> 16); }
        __syncthreads();
#pragma unroll 1
        for (int pass = 0; pass < 2; ++pass) {
            const size_t t = (size_t)b * SEQ + tb * 256 + wave * 32 + pass * 16 + fr;
            bf16x8v qf[2];
#pragma unroll
            for (int ks = 0; ks < 2; ++ks) qf[ks] = *(const GAS bf16x8v*)(P.proj + t * LDP + PC_MQ + h * XAD + 32 * ks + 8 * fq);
            f32x4 s[16];
#pragma unroll
            for (int tl = 0; tl < 16; ++tl) { s[tl] = (f32x4){0.f, 0.f, 0.f, 0.f};
#pragma unroll
                for (int ks = 0; ks < 2; ++ks) { const bf16x8v a = *(const LAS bf16x8v*)(KL + (16 * tl + fr) * KST + (32 * ks + 8 * fq) * 2); s[tl] = __builtin_amdgcn_mfma_f32_16x16x32_bf16(a, qf[ks], s[tl], 0, 0, 0); } }
            float mx = -3.0e38f;
#pragma unroll
            for (int tl = 0; tl < 16; ++tl) mx = fmaxf(mx, fmaxf(fmaxf(s[tl][0], s[tl][1]), fmaxf(s[tl][2], s[tl][3])));
            mx = fmaxf(mx, __shfl_xor(mx, 16)); mx = fmaxf(mx, __shfl_xor(mx, 32));
            float ps = 0.f;
#pragma unroll
            for (int tl = 0; tl < 16; ++tl)
#pragma unroll
                for (int r = 0; r < 4; ++r) { const float pv = exp2f((s[tl][r] - mx) * 0.18033688011112042f); s[tl][r] = pv; ps += pv; }
            ps += __shfl_xor(ps, 16); ps += __shfl_xor(ps, 32);
            f32x4 o[4];
#pragma unroll
            for (int dt = 0; dt < 4; ++dt) o[dt] = (f32x4){0.f, 0.f, 0.f, 0.f};
#pragma unroll
            for (int ks = 0; ks < 8; ++ks) {
                v4u pw; pw.x = cvtpk(s[2 * ks][0], s[2 * ks][1]); pw.y = cvtpk(s[2 * ks][2], s[2 * ks][3]); pw.z = cvtpk(s[2 * ks + 1][0], s[2 * ks + 1][1]); pw.w = cvtpk(s[2 * ks + 1][2], s[2 * ks + 1][3]);
                const bf16x8v pf = __builtin_bit_cast(bf16x8v, pw);
#pragma unroll
                for (int dt = 0; dt < 4; ++dt) { const bf16x8v a = *(const LAS bf16x8v*)(VL + (16 * dt + fr) * VST + (32 * ks + 8 * fq) * 2); o[dt] = __builtin_amdgcn_mfma_f32_16x16x32_bf16(a, pf, o[dt], 0, 0, 0); }
            }
            const float inv = 1.f / ps;
#pragma unroll
            for (int dt = 0; dt < 4; ++dt) { v2u w; w.x = cvtpk(o[dt][0] * inv, o[dt][1] * inv); w.y = cvtpk(o[dt][2] * inv, o[dt][3] * inv);
                *(GAS v2u*)(P.abuf + t * D + MIXW + h * XAD + 16 * dt + 4 * fq) = w; }
        }
        __syncthreads();
    }
}

__device__ __forceinline__ void ph_convgate(const Ptrs& P, int l, int gtid, int NT) {
    if (SKIPMASK & 512) return;
    const float* w = P.ffn_conv_w + (size_t)l * 3 * DFF2; const float* bs = P.ffn_conv_b + (size_t)l * DFF2;
    for (int idx = gtid; idx < M * (DFF / 8); idx += NT) {
        const int cg = idx % (DFF / 8), t = idx / (DFF / 8), c0 = cg * 8, pos = t % SEQ;
        float yg[8], yv[8];
        { const f32x4 a0 = *(const GAS f32x4*)(bs + c0), a1 = *(const GAS f32x4*)(bs + c0 + 4), b0 = *(const GAS f32x4*)(bs + DFF + c0), b1 = *(const GAS f32x4*)(bs + DFF + c0 + 4);
          yg[0] = a0.x; yg[1] = a0.y; yg[2] = a0.z; yg[3] = a0.w; yg[4] = a1.x; yg[5] = a1.y; yg[6] = a1.z; yg[7] = a1.w;
          yv[0] = b0.x; yv[1] = b0.y; yv[2] = b0.z; yv[3] = b0.w; yv[4] = b1.x; yv[5] = b1.y; yv[6] = b1.z; yv[7] = b1.w; }
#pragma unroll
        for (int k = 0; k < 3; ++k) {
            if (pos - 2 + k < 0) continue;
            const size_t row = (size_t)(t - 2 + k);
            const v4u ug = *(const GAS v4u*)(P.u + row * DFF2 + c0), uv = *(const GAS v4u*)(P.u + row * DFF2 + DFF + c0);
            const f32x4 g0 = *(const GAS f32x4*)(w + k * DFF2 + c0), g1 = *(const GAS f32x4*)(w + k * DFF2 + c0 + 4), v0 = *(const GAS f32x4*)(w + k * DFF2 + DFF + c0), v1 = *(const GAS f32x4*)(w + k * DFF2 + DFF + c0 + 4);
            yg[0] += g0.x * bflo(ug.x); yg[1] += g0.y * bfhi(ug.x); yg[2] += g0.z * bflo(ug.y); yg[3] += g0.w * bfhi(ug.y); yg[4] += g1.x * bflo(ug.z); yg[5] += g1.y * bfhi(ug.z); yg[6] += g1.z * bflo(ug.w); yg[7] += g1.w * bfhi(ug.w);
            yv[0] += v0.x * bflo(uv.x); yv[1] += v0.y * bfhi(uv.x); yv[2] += v0.z * bflo(uv.y); yv[3] += v0.w * bfhi(uv.y); yv[4] += v1.x * bflo(uv.z); yv[5] += v1.y * bfhi(uv.z); yv[6] += v1.z * bflo(uv.w); yv[7] += v1.w * bfhi(uv.w);
        }
        float hv[8];
#pragma unroll
        for (int e = 0; e < 8; ++e) hv[e] = (yg[e] / (1.f + expf(-yg[e]))) * yv[e];
        v4u o; o.x = pk2(hv[0], hv[1]); o.y = pk2(hv[2], hv[3]); o.z = pk2(hv[4], hv[5]); o.w = pk2(hv[6], hv[7]);
        *(GAS v4u*)(P.h + (size_t)t * DFF + c0) = o;
    }
}

constexpr int N_PHASES = 1 + 2 * 11 + 2 * 8;
struct Args { const float* in[19]; float* out; unsigned char* ws; int ph_lo, ph_hi, li, pad; };
__global__ void __launch_bounds__(NWAVES * 64, 2) trunk_fwd(Args args) {
    extern __shared__ __attribute__((aligned(16))) unsigned char lds_raw[];
    LAS unsigned char* lds = (LAS unsigned char*)lds_raw;
    volatile LAS unsigned* MISC = (volatile LAS unsigned*)(lds + MISC_OFF);
    const int G = gridDim.x, NT = G * NWAVES * 64, NGW = G * NWAVES;
    unsigned char* ws = args.ws;
    LAS unsigned long long* PT = (LAS unsigned long long*)(lds + PTAB_OFF);
    if (threadIdx.x == 0) {
        PT[0] = (unsigned long long)args.in[0]; PT[1] = (unsigned long long)args.in[1]; PT[2] = (unsigned long long)args.in[2]; PT[3] = (unsigned long long)args.in[3]; PT[4] = (unsigned long long)args.in[4];
        PT[5] = (unsigned long long)args.in[5]; PT[6] = (unsigned long long)args.in[6]; PT[7] = (unsigned long long)args.in[7]; PT[8] = (unsigned long long)args.in[8]; PT[9] = (unsigned long long)args.in[9];
        PT[10] = (unsigned long long)args.in[10]; PT[11] = (unsigned long long)args.in[11]; PT[12] = (unsigned long long)args.in[12]; PT[13] = (unsigned long long)args.in[13]; PT[14] = (unsigned long long)args.in[14];
        PT[15] = (unsigned long long)args.in[15]; PT[16] = (unsigned long long)args.in[16]; PT[17] = (unsigned long long)args.in[17]; PT[18] = (unsigned long long)args.in[18]; PT[19] = (unsigned long long)args.out;
    }
    if (threadIdx.x < 64) MISC[threadIdx.x] = 0u;
    __syncthreads();
    XcdBarrier bar; bar.bar = (unsigned*)(ws + WS_CTL) + CW_BAR; bar.x = 0; bar.st = nullptr;
#if ONE_LAUNCH
    bar = xcd_barrier_post((unsigned*)(ws + WS_CTL) + CW_BAR, MISC + 8);
#endif
    const int lo = args.ph_lo, hi = args.ph_hi;
    int p = 0;
#if ONE_LAUNCH
#define GRID_BAR() xcd_barrier(bar)
#else
#define GRID_BAR() do {} while (0)
#endif
#define RUN(...) do { if (p >= lo && p < hi) { int tid = threadIdx.x; asm volatile("" : "+v"(tid)); int bid = blockIdx.x; asm volatile("" : "+s"(bid)); \
        const int lane = tid & 63, wave = __builtin_amdgcn_readfirstlane(tid >> 6), gtid = bid * (NWAVES * 64) + tid, gw = bid * NWAVES + wave; (void)lane; (void)gtid; (void)gw; \
        Ptrs P; load_ptrs(P, PT, ws); __VA_ARGS__; if (p + 1 < hi) GRID_BAR(); } ++p; } while (0)

    RUN(ph_prologue(P, gtid, NT); ph_convert(P, 0, lds, gw, NGW, lane, gtid, NT));
    for (int l = 0; l < DEPTH; ++l) {
        const bool gla = (l & 1) == 0; const int j = l >> 1;
        RUN({ pg8::Gemm g{P.xn, P.win, M, gla ? LDP : CONV_IN, D}; pg8::StaticOrder S; S.init(M, gla ? LDP : CONV_IN, G, bid);
              pg8::EpiBf16 E{P.proj, LDP};
              if (!(SKIPMASK & 1024)) pg8::gemm_phase<pg8::EpiBf16, pg8::StaticOrder, true, true>(lds + RING_OFF, g, S, E, tid);
              pg8::Gemm g2{P.memb, P.wmkv, MM, 512, D}; pg8::StaticOrder S2; S2.init(MM, 512, G, bid);
              pg8::EpiBf16 E2{P.memkv, 512};
              if (!(SKIPMASK & 1024)) pg8::gemm_phase<pg8::EpiBf16, pg8::StaticOrder, true, true>(lds + RING_OFF, g2, S2, E2, tid); });
        RUN({ if (gla) { REP(8) ph_gla_g(P, j, gtid, NT); } else { REP(128) ph_conv_mix(P, j, gtid, NT); }
              REP(256) { if (XATTN_MFMA) ph_xattn_mfma(P, lds, tid, bid, G); else ph_xattn(P, lds, tid, bid, G); } });
        if (gla) {
            RUN(REP(16) ph_gla_kv(P, lds, tid, bid, G));
            RUN(ph_gla_scan(P, gtid, NT));
            RUN(REP(64) ph_gla_out(P, j, lds, tid, bid, G));
        }
        RUN({ pg8::Gemm g{P.abuf, P.wout, M, D, D}; pg8::StaticOrder S; S.init(M, D, G, bid);
              pg8::EpiResid E{P.xres, D, DN_ALPHA};
              if (!(SKIPMASK & 1024)) pg8::gemm_phase<pg8::EpiResid, pg8::StaticOrder, true, true>(lds + RING_OFF, g, S, E, tid); });
        RUN(ph_ln(P, P.ln1_g + (size_t)l * D, P.ln1_b + (size_t)l * D, gw, NGW, lane));
        RUN({ pg8::Gemm g{P.xn, P.wup, M, DFF2, D}; pg8::StaticOrder S; S.init(M, DFF2, G, bid);
              pg8::EpiBf16 E{P.u, DFF2};
              if (!(SKIPMASK & 1024)) pg8::gemm_phase<pg8::EpiBf16, pg8::StaticOrder, true, true>(lds + RING_OFF, g, S, E, tid); });
        RUN(REP(512) ph_convgate(P, l, gtid, NT));
        RUN({ pg8::Gemm g{P.h, P.wdn, M, D, DFF}; pg8::StaticOrder S; S.init(M, D, G, bid);
              pg8::EpiResid E{P.xres, D, DN_ALPHA};
              if (!(SKIPMASK & 1024)) pg8::gemm_phase<pg8::EpiResid, pg8::StaticOrder, true, true>(lds + RING_OFF, g, S, E, tid); });
        RUN({ ph_ln(P, P.ln2_g + (size_t)l * D, P.ln2_b + (size_t)l * D, gw, NGW, lane);
              if (l + 1 < DEPTH) { REP(2) ph_convert(P, l + 1, lds, gw, NGW, lane, gtid, NT); } });
    }
#undef RUN
}

extern "C" void kernel_launch(void* const* d_in, const int* in_sizes, int n_in, void* d_out, int out_size, void* d_ws, size_t ws_size, hipStream_t stream) {
    static int grid = 0;
    if (grid == 0) {
        if (n_in != 19 || out_size != M * D || ws_size < WS_END) { fprintf(stderr, "kernel_launch: unexpected shapes: n_in %d out %d ws %zu\n", n_in, out_size, ws_size); grid = -1; return; }
        int dev = 0, cus = 0, per_cu = 0;
        if (hipGetDevice(&dev) != hipSuccess || hipDeviceGetAttribute(&cus, hipDeviceAttributeMultiprocessorCount, dev) != hipSuccess) { grid = -1; return; }
        if (hipFuncSetAttribute((const void*)trunk_fwd, hipFuncAttributeMaxDynamicSharedMemorySize, LDS_BYTES) != hipSuccess) { fprintf(stderr, "kernel_launch: hipFuncSetAttribute failed\n"); grid = -1; return; }
        if (hipOccupancyMaxActiveBlocksPerMultiprocessor(&per_cu, (const void*)trunk_fwd, NWAVES * 64, LDS_BYTES) != hipSuccess || per_cu < 1) { fprintf(stderr, "kernel_launch: occupancy query says %d\n", per_cu); }
        (void)hipGetLastError();
        grid = cus;
    }
    if (grid < 0) return;
    if (hipMemsetAsync((char*)d_ws + WS_CTL, 0, CTL_ZERO_BYTES, stream) != hipSuccess) return;
    Args a{};
    for (int i = 0; i < 19; ++i) a.in[i] = (const float*)d_in[i];
    a.out = (float*)d_out; a.ws = (unsigned char*)d_ws;
#if ONE_LAUNCH
    a.ph_lo = 0; a.ph_hi = N_PHASES; a.li = 0;
    hipLaunchKernelGGL(trunk_fwd, dim3(grid), dim3(NWAVES * 64), LDS_BYTES, stream, a);
#else
    for (int p = 0; p < N_PHASES; ++p) { a.ph_lo = p; a.ph_hi = p + 1; a.li = p; hipLaunchKernelGGL(trunk_fwd, dim3(grid), dim3(NWAVES * 64), LDS_BYTES, stream, a); }
#endif
}
```

```cpp
#include <hip/hip_runtime.h>
#include <cstdio>
#include <cstdint>

#ifndef ONE_LAUNCH
#define ONE_LAUNCH 1
#endif

namespace pg8 {
#define PG8_LAS __attribute__((address_space(3)))
typedef unsigned short bf16_t;
typedef short bf16x8 __attribute__((ext_vector_type(8)));
typedef float f32x4 __attribute__((ext_vector_type(4)));
typedef unsigned u32x4 __attribute__((ext_vector_type(4)));
constexpr int BM = 256, BK = 64, HALF = 128, HTB = HALF * BK * 2  , STAGE_BYTES = 8 * HTB, NXCD = 8, WGM = 8;

__host__ __device__ __forceinline__ int lds_byte(int r, int c) { const int st = (r >> 4) * 2 + (c >> 5), rr = r & 15, cc = c & 31, ob = rr * 64 + cc * 2; return st * 1024 + (ob ^ (((ob >> 9) & 1) << 5)); }
__host__ __device__ __forceinline__ void stage_rc(int b, int& R, int& C) { const int st = b / 1024, sb = b % 1024, swz = sb ^ (((sb >> 9) & 1) << 5); R = (st >> 1) * 16 + swz / 64; C = (st & 1) * 32 + (swz % 64) / 2; }
__host__ __device__ __forceinline__ int perm32(int rho) { const int n = rho >> 4, i = rho & 15; return 8 * (i >> 2) + 4 * n + (i & 3); }

struct Unit { int pm, pn; };
struct Gemm { const bf16_t* A; const bf16_t* Bt; int M, N, K; };

struct StaticOrder {
    int nM, nN, nwg, G, c;
    __host__ __device__ void init(int M, int N, int G_, int c_) { nM = M / BM; nN = N / BM; nwg = nM * nN; G = G_; c = c_; }
    __host__ __device__ bool next(int i, Unit& u) const {
        const long L = (long)i * G + c; if (L >= nwg) return false;
        int wgid = (int)L; { const int q = nwg / NXCD, r = nwg % NXCD, xcd = wgid % NXCD, off = wgid / NXCD; wgid = (xcd < r ? xcd * (q + 1) : r * (q + 1) + (xcd - r) * q) + off; }
        const int nig = WGM * nN, gid = wgid / nig, fm = gid * WGM, gsz = (nM - fm) < WGM ? (nM - fm) : WGM;
        u.pm = fm + ((wgid % nig) % gsz); u.pn = (wgid % nig) / gsz; return true;
    }
    __device__ __forceinline__ void a_ready(const Unit&) const {}
    __device__ __forceinline__ void done(const Unit&) const {}
};


__device__ __forceinline__ unsigned cvt_pk_bf16(float lo, float hi) { unsigned r; asm volatile("v_cvt_pk_bf16_f32 %0, %1, %2" : "=v"(r) : "v"(lo), "v"(hi)); return r; }

struct EpiBf16 {
    static constexpr bool PERM = true, AFTER_DRAIN = false;
    bf16_t* O; int ldc;
    __device__ __forceinline__ void operator()(const f32x4 (&acc)[2][2][4][2], const Unit& u, int wr, int wc, int fr, int fq) const {
        const int row0 = u.pm * BM + wr * 64 + fr; const int col0 = u.pn * BM + wc * 32 + 8 * fq;
#pragma unroll
        for (int ai = 0; ai < 2; ++ai)
#pragma unroll
            for (int m = 0; m < 4; ++m) { bf16_t* rowp = O + (size_t)(row0 + ai * HALF + m * 16) * ldc + col0;
#pragma unroll
                for (int bj = 0; bj < 2; ++bj) { const f32x4 v0 = acc[ai][bj][m][0], v1 = acc[ai][bj][m][1];
                    u32x4 w; w.x = cvt_pk_bf16(v0[0], v0[1]); w.y = cvt_pk_bf16(v0[2], v0[3]); w.z = cvt_pk_bf16(v1[0], v1[1]); w.w = cvt_pk_bf16(v1[2], v1[3]);
                    *(u32x4*)(rowp + bj * HALF) = w; } }
    }
};
struct EpiResid {
    static constexpr bool PERM = false, AFTER_DRAIN = false;
    float* X; int ldc; float alpha;
    __device__ __forceinline__ void operator()(const f32x4 (&acc)[2][2][4][2], const Unit& u, int wr, int wc, int fr, int fq) const {
        const int row0 = u.pm * BM + wr * 64 + fr, col0 = u.pn * BM + wc * 32 + 4 * fq;
#pragma unroll
        for (int ai = 0; ai < 2; ++ai)
#pragma unroll
            for (int m = 0; m < 4; ++m) { float* rowp = X + (size_t)(row0 + ai * HALF + m * 16) * ldc + col0;
#pragma unroll
                for (int bj = 0; bj < 2; ++bj)
#pragma unroll
                    for (int n = 0; n < 2; ++n) { f32x4* p = (f32x4*)(rowp + bj * HALF + n * 16); const f32x4 o = *p; *p = o * alpha + acc[ai][bj][m][n]; } }
    }
};

template <class Epi, class Sched, bool ALIGN_EPI = false, bool SP2 = false>
__device__ __forceinline__ void gemm_phase(PG8_LAS unsigned char* lds, const Gemm g, const Sched& S, const Epi& E, const int tid) {
    const int wid = __builtin_amdgcn_readfirstlane(tid >> 6), lane = tid & 63, wr = wid >> 2, wc = wid & 3, fr = lane & 15, fq = lane >> 4;
    const int K = g.K, nt = K / BK;
    unsigned voffA[2], voffB[2];
#pragma unroll
    for (int i = 0; i < 2; ++i) { int R, C; stage_rc(tid * 16 + i * 8192, R, C); const int Rb = Epi::PERM ? ((R & ~31) + perm32(R & 31)) : R;
        voffA[i] = (unsigned)(R * K + C) * 2u; voffB[i] = (unsigned)(Rb * K + C) * 2u; }
    const size_t kstep = (size_t)(BK * 2);
    const size_t hstep = (size_t)HALF * K * 2;
    const size_t tstep = 2 * hstep;
    const unsigned ldsw = (unsigned)wid * 1024u;
    const int aoff = lds_byte(wr * 64 + fr, fq * 8), boff = lds_byte(wc * 32 + fr, fq * 8);
#define PG8_SA(b, h) (((b) * 2 + (h)) * HTB)
#define PG8_SB(b, h) ((4 + (b) * 2 + (h)) * HTB)
#define PG8_STAGE(bufoff, gbase, voff) do { _Pragma("unroll") for (int _i = 0; _i < 2; ++_i) \
        __builtin_amdgcn_global_load_lds((const unsigned*)((const char*)(gbase) + (voff)[_i]), (PG8_LAS unsigned*)(lds + (bufoff) + ldsw + _i * 8192), 16, 0, 0); } while (0)
#define PG8_LDA(dst, b, h) do { _Pragma("unroll") for (int m = 0; m < 4; ++m) _Pragma("unroll") for (int k = 0; k < 2; ++k) dst[m][k] = *(const PG8_LAS bf16x8*)(lds + PG8_SA(b, h) + aoff + m * 2048 + k * 1024); } while (0)
#define PG8_LDB(dst, b, h) do { _Pragma("unroll") for (int n = 0; n < 2; ++n) _Pragma("unroll") for (int k = 0; k < 2; ++k) dst[n][k] = *(const PG8_LAS bf16x8*)(lds + PG8_SB(b, h) + boff + n * 2048 + k * 1024); } while (0)
#define PG8_MMA(ai, bj, At, Bt) do { __builtin_amdgcn_s_setprio(1); _Pragma("unroll") for (int m = 0; m < 4; ++m) _Pragma("unroll") for (int n = 0; n < 2; ++n) _Pragma("unroll") for (int k = 0; k < 2; ++k) \
        acc[ai][bj][m][n] = __builtin_amdgcn_mfma_f32_16x16x32_bf16(Bt[n][k], At[m][k], acc[ai][bj][m][n], 0, 0, 0); __builtin_amdgcn_s_setprio(0); } while (0)
#define PG8_WAIT_V(n) asm volatile("s_waitcnt vmcnt(" #n ")" ::: "memory")
#define PG8_WAIT_L(n) asm volatile("s_waitcnt lgkmcnt(" #n ")" ::: "memory")
#define PG8_BAR __builtin_amdgcn_s_barrier()
#define PG8_SCHED __builtin_amdgcn_sched_barrier(0)
    Unit cur, nxt; int ui = 0;
    if (!S.next(0, cur)) return;
    f32x4 acc[2][2][4][2];
#pragma unroll
    for (int a = 0; a < 2; ++a)
#pragma unroll
        for (int b = 0; b < 2; ++b)
#pragma unroll
            for (int m = 0; m < 4; ++m)
#pragma unroll
                for (int n = 0; n < 2; ++n) acc[a][b][m][n] = (f32x4){0.f, 0.f, 0.f, 0.f};
    bf16x8 At[4][2], B0[2][2], B1[2][2];
    const char* cA = (const char*)g.A + (size_t)cur.pm * tstep; const char* cB = (const char*)g.Bt + (size_t)cur.pn * tstep;
    S.a_ready(cur);
    if constexpr (SP2) {
        PG8_STAGE(PG8_SB(0, 0), cB, voffB); PG8_STAGE(PG8_SB(0, 1), cB + hstep, voffB); PG8_STAGE(PG8_SA(0, 0), cA, voffA); PG8_STAGE(PG8_SA(0, 1), cA + hstep, voffA);
        if (wr == 1) PG8_BAR;
        PG8_WAIT_V(2); PG8_BAR;
        PG8_STAGE(PG8_SB(1, 0), cB + kstep, voffB); PG8_STAGE(PG8_SA(1, 0), cA + kstep, voffA); PG8_STAGE(PG8_SB(1, 1), cB + hstep + kstep, voffB);
        PG8_WAIT_V(6); PG8_BAR;
    } else {
        PG8_STAGE(PG8_SB(0, 0), cB, voffB); PG8_STAGE(PG8_SA(0, 0), cA, voffA); PG8_STAGE(PG8_SB(0, 1), cB + hstep, voffB); PG8_STAGE(PG8_SA(0, 1), cA + hstep, voffA);
        if (wr == 1) PG8_BAR;
        PG8_WAIT_V(4); PG8_BAR;
        PG8_STAGE(PG8_SB(1, 0), cB + kstep, voffB); PG8_STAGE(PG8_SA(1, 0), cA + kstep, voffA); PG8_STAGE(PG8_SB(1, 1), cB + hstep + kstep, voffB);
        PG8_WAIT_V(6); PG8_BAR;
    }
    for (;;) {
        const bool has_next = S.next(ui + 1, nxt);
        const char* nA = has_next ? (const char*)g.A + (size_t)nxt.pm * tstep : cA; const char* nB = has_next ? (const char*)g.Bt + (size_t)nxt.pn * tstep : cB;
        for (int t = 0; t < nt; t += 2) {
            const bool last = (t == nt - 2);
            const char* a1 = cA + (size_t)(t + 1) * kstep;
            const char* a2 = last ? nA : cA + (size_t)(t + 2) * kstep; const char* b2 = last ? nB : cB + (size_t)(t + 2) * kstep;
            const char* a3 = a2 + kstep; const char* b3 = b2 + kstep;
            if (last && has_next) S.a_ready(nxt);
            if constexpr (SP2) {
            PG8_LDB(B0, 0, 0); PG8_LDB(B1, 0, 1); PG8_SCHED; PG8_LDA(At, 0, 0); PG8_STAGE(PG8_SA(1, 1), a1 + hstep, voffA);
            PG8_WAIT_V(8); PG8_WAIT_L(0); PG8_BAR; PG8_MMA(0, 0, At, B0); PG8_MMA(0, 1, At, B1); PG8_BAR; PG8_SCHED;
            PG8_LDA(At, 0, 1); PG8_STAGE(PG8_SB(0, 0), b2, voffB); PG8_STAGE(PG8_SB(0, 1), b2 + hstep, voffB); PG8_STAGE(PG8_SA(0, 0), a2, voffA);
            PG8_WAIT_V(8); PG8_WAIT_L(0); PG8_BAR; PG8_MMA(1, 0, At, B0); PG8_MMA(1, 1, At, B1); PG8_BAR; PG8_SCHED;
            PG8_LDB(B0, 1, 0); PG8_LDB(B1, 1, 1); PG8_SCHED; PG8_LDA(At, 1, 0); PG8_STAGE(PG8_SA(0, 1), a2 + hstep, voffA);
            PG8_WAIT_V(8); PG8_WAIT_L(0); PG8_BAR; PG8_MMA(0, 0, At, B0); PG8_MMA(0, 1, At, B1); PG8_BAR; PG8_SCHED;
            PG8_LDA(At, 1, 1); PG8_STAGE(PG8_SB(1, 0), b3, voffB); PG8_STAGE(PG8_SB(1, 1), b3 + hstep, voffB); PG8_STAGE(PG8_SA(1, 0), a3, voffA);
            PG8_WAIT_V(8); PG8_WAIT_L(0); PG8_BAR; PG8_MMA(1, 0, At, B0); PG8_MMA(1, 1, At, B1); PG8_BAR; PG8_SCHED;
            } else {
            PG8_LDB(B0, 0, 0); PG8_SCHED; PG8_LDA(At, 0, 0); PG8_STAGE(PG8_SA(1, 1), a1 + hstep, voffA);
            PG8_WAIT_L(8); PG8_BAR; PG8_WAIT_L(0); PG8_MMA(0, 0, At, B0); PG8_BAR; PG8_SCHED;
            PG8_LDB(B1, 0, 1); PG8_STAGE(PG8_SB(0, 0), b2, voffB);
            PG8_BAR; PG8_WAIT_L(0); PG8_MMA(0, 1, At, B1); PG8_BAR;
            PG8_LDA(At, 0, 1); PG8_STAGE(PG8_SA(0, 0), a2, voffA);
            PG8_BAR; PG8_WAIT_L(0); PG8_MMA(1, 0, At, B0); PG8_BAR; PG8_SCHED;
            PG8_STAGE(PG8_SB(0, 1), b2 + hstep, voffB);
            PG8_WAIT_V(6); PG8_BAR; PG8_MMA(1, 1, At, B1); PG8_BAR;
            PG8_LDB(B0, 1, 0); PG8_SCHED; PG8_LDA(At, 1, 0); PG8_STAGE(PG8_SA(0, 1), a2 + hstep, voffA);
            PG8_WAIT_L(8); PG8_BAR; PG8_WAIT_L(0); PG8_MMA(0, 0, At, B0); PG8_BAR; PG8_SCHED;
            PG8_LDB(B1, 1, 1); PG8_STAGE(PG8_SB(1, 0), b3, voffB);
            PG8_BAR; PG8_WAIT_L(0); PG8_MMA(0, 1, At, B1); PG8_BAR;
            PG8_LDA(At, 1, 1); PG8_STAGE(PG8_SA(1, 0), a3, voffA);
            PG8_BAR; PG8_WAIT_L(0); PG8_MMA(1, 0, At, B0); PG8_BAR; PG8_SCHED;
            PG8_STAGE(PG8_SB(1, 1), b3 + hstep, voffB);
            PG8_WAIT_V(6); PG8_BAR; PG8_MMA(1, 1, At, B1); PG8_BAR;
            }
        }
        if constexpr (ALIGN_EPI) { if (wr == 0) PG8_BAR; }
        if constexpr (!Epi::AFTER_DRAIN) { E(acc, cur, wr, wc, fr, fq); S.done(cur); }
        if (!has_next) break;
#pragma unroll
        for (int a = 0; a < 2; ++a)
#pragma unroll
            for (int b = 0; b < 2; ++b)
#pragma unroll
                for (int m = 0; m < 4; ++m)
#pragma unroll
                    for (int n = 0; n < 2; ++n) acc[a][b][m][n] = (f32x4){0.f, 0.f, 0.f, 0.f};
        cur = nxt; cA = nA; cB = nB; ++ui;
        if constexpr (ALIGN_EPI) { if (wr == 1) PG8_BAR; }
    }
    PG8_WAIT_V(0);
    if constexpr (!ALIGN_EPI) { if (wr == 0) PG8_BAR; }
    PG8_BAR;
    if constexpr (Epi::AFTER_DRAIN) { E.fused(acc, cur, wr, wc, fr, fq, lds, wid, lane); S.done(cur); }
#undef PG8_SA
#undef PG8_SB
#undef PG8_STAGE
#undef PG8_LDA
#undef PG8_LDB
#undef PG8_MMA
#undef PG8_WAIT_V
#undef PG8_WAIT_L
#undef PG8_BAR
#undef PG8_SCHED
}
}

constexpr int NWAVES = 8;
constexpr int BATCH = 8, SEQ = 2048, D = 1024, DEPTH = 4;
constexpr int M = BATCH * SEQ;
constexpr int NMEM = 256, MM = BATCH * NMEM;
constexpr int XAW = 256, XAH = 4, XAD = 64, MIXW = 768;
constexpr int GH = 4, GDK = 384, GDV = 768, GHK = 96, GHV = 192, RANK = 16, CH = 64, NCH = SEQ / CH;
constexpr int DFF = 2816, DFF2 = 5632;
constexpr int GLA_IN = 2576, CONV_IN = 2560, LDP = 2816;
constexpr float LN_EPS = 1e-5f;
constexpr float DN_ALPHA = 1.6817928305074292f;
constexpr int PC_Q = 0, PC_K = 384, PC_V = 768, PC_R = 1536, PC_MQ = 2304, PC_GATE = 2560;
constexpr int PC_B = 0, PC_C = 768, PC_H = 1536;
constexpr int NUNITS_GLA = BATCH * GH * NCH;

constexpr size_t MiB = 1u << 20;
constexpr size_t WS_CTL = 0, CTL_ZERO_BYTES = 1 * MiB;
constexpr size_t WS_WIN = 1 * MiB;
constexpr size_t WS_WOUT = WS_WIN + 5 * MiB + MiB / 2;
constexpr size_t WS_WUP = WS_WOUT + 2 * MiB;
constexpr size_t WS_WDN = WS_WUP + 11 * MiB;
constexpr size_t WS_WMKV = WS_WDN + 5 * MiB + MiB / 2;
constexpr size_t WS_XN = 27 * MiB;
constexpr size_t WS_PROJ = 60 * MiB;
constexpr size_t WS_ABUF = 148 * MiB;
constexpr size_t WS_GB = 180 * MiB;
constexpr size_t WS_MEMKV = 204 * MiB;
constexpr size_t WS_U = 60 * MiB;
constexpr size_t WS_H = 236 * MiB;
constexpr size_t WS_ST = 236 * MiB;
constexpr size_t WS_DEC = 308 * MiB;
constexpr size_t WS_MEMB = 324 * MiB;
constexpr size_t WS_END = 328 * MiB;
static_assert(WS_WMKV + 1 * MiB <= WS_XN && WS_U + (size_t)M * DFF2 * 2 <= WS_H && WS_DEC + (size_t)NUNITS_GLA * GHK * 4 <= WS_MEMB, "d_ws map");
constexpr int CW_BAR = 4096;

constexpr int LDS_BYTES = 163840;
constexpr int RING_OFF = 0;
constexpr int MISC_OFF = 163840 - 256;
constexpr int PTAB_OFF = 163840 - 512;

#define GAS __attribute__((address_space(1)))
#define LAS __attribute__((address_space(3)))
typedef unsigned short bf16;
typedef unsigned v4u __attribute__((ext_vector_type(4)));
typedef unsigned v2u __attribute__((ext_vector_type(2)));
typedef float f32x4 __attribute__((ext_vector_type(4)));
typedef GAS unsigned gu32;
#define RLX_AGENT __ATOMIC_RELAXED, __HIP_MEMORY_SCOPE_AGENT
#define LDS_WAIT() asm volatile("s_waitcnt lgkmcnt(0)" ::: "memory")
__device__ __forceinline__ unsigned f2bf(float f) { unsigned u = __builtin_bit_cast(unsigned, f); return (u + 0x7fffu + ((u >> 16) & 1u)) >> 16; }
__device__ __forceinline__ unsigned pk2(float lo, float hi) { return f2bf(lo) | (f2bf(hi) << 16); }
__device__ __forceinline__ float bf2f(unsigned short b) { return __uint_as_float(((unsigned)b) << 16); }
__device__ __forceinline__ float bflo(unsigned w) { return __uint_as_float(w << 16); }
__device__ __forceinline__ float bfhi(unsigned w) { return __uint_as_float(w & 0xffff0000u); }
__device__ __forceinline__ float wave_sum(float v) {
#pragma unroll
    for (int o = 1; o < 64; o <<= 1) v += __shfl_xor(v, o);
    return v;
}
__device__ __forceinline__ float wave_max(float v) {
#pragma unroll
    for (int o = 1; o < 64; o <<= 1) v = fmaxf(v, __shfl_xor(v, o));
    return v;
}
#define XB_TMO      128
#define XB_XCNT(j)  (256  + 64 * (j))
#define XB_XSUB(j)  (1280 + 64 * (j))
#define XB_XGEN(j)  (2304 + 64 * (j))
#define XB_TOP      3328
#define XB_TOPGEN   3392
#define XCD_BAR_WORDS 3456
#define XB_SPIN_CAP (1u << 18)

__device__ __forceinline__ unsigned xb_ld(unsigned* p)              { return __hip_atomic_load(p, __ATOMIC_RELAXED, __HIP_MEMORY_SCOPE_AGENT); }
__device__ __forceinline__ unsigned xb_add(unsigned* p, unsigned v) { return __hip_atomic_fetch_add(p, v, __ATOMIC_RELAXED, __HIP_MEMORY_SCOPE_AGENT); }
__device__ __forceinline__ unsigned xb_xcc_id() { return (unsigned)__builtin_amdgcn_s_getreg((3 << 11) | 20) & 0xFu; }
#define XB_SPIN(cond, bar) do { unsigned _sp = 0; while (cond) { __builtin_amdgcn_s_sleep(1); \
    if ((++_sp & 255u) == 0u) { if (xb_ld(&(bar)[XB_TMO])) break; if (_sp > XB_SPIN_CAP) { atomicAdd(&(bar)[XB_TMO], 1u); break; } } } } while (0)

struct XcdBarrier {
    unsigned* bar; unsigned x;
    volatile LAS unsigned* st;
};

__device__ __forceinline__ XcdBarrier xcd_barrier_post(unsigned* bar, volatile LAS unsigned* st) {
    XcdBarrier b; b.bar = bar; b.x = xb_xcc_id(); b.st = st;
    if (threadIdx.x == 0) (void)xb_add(&bar[XB_XCNT(b.x)], 1u);
    return b;
}
__device__ __forceinline__ void xcd_barrier_complete(unsigned* bar, unsigned x, unsigned& nloc, unsigned& nx) {
    const unsigned G = gridDim.x * gridDim.y * gridDim.z;
    unsigned sum, cnt, mine, sp = 0u;
    for (;;) {
        sum = 0u; cnt = 0u; mine = 0u;
#pragma unroll
        for (unsigned j = 0; j < 16; ++j) { const unsigned c = xb_ld(&bar[XB_XCNT(j)]); sum += c; cnt += (c > 0u) ? 1u : 0u; mine = (j == x) ? c : mine; }
        if (sum == G) break;
        __builtin_amdgcn_s_sleep(1);
        if ((++sp & 255u) == 0u) { if (xb_ld(&bar[XB_TMO])) break; if (sp > XB_SPIN_CAP) { atomicAdd(&bar[XB_TMO], 1u); break; } }
    }
    nloc = mine > 0u ? mine : 1u; nx = cnt > 0u ? cnt : 1u;
}

__device__ __forceinline__ void xcd_barrier(const XcdBarrier& b) {
    asm volatile("s_waitcnt vmcnt(0)" ::: "memory");
    __syncthreads();
    if (threadIdx.x == 0) {
        unsigned* bar = b.bar;
        __builtin_amdgcn_s_waitcnt(0);
        unsigned nloc = b.st[0], nx = b.st[1];
        if (nloc == 0u) { xcd_barrier_complete(bar, b.x, nloc, nx); b.st[0] = nloc; b.st[1] = nx; }
        const unsigned old = xb_add(&bar[XB_XSUB(b.x)], 1u);
        const unsigned gen = old / nloc;
        if (old + 1u == (gen + 1u) * nloc) {
            __builtin_amdgcn_fence(__ATOMIC_RELEASE, "agent");
            asm volatile("s_waitcnt vmcnt(0)" ::: "memory");
            const unsigned og = xb_add(&bar[XB_TOP], 1u);
            const unsigned tg = og / nx;
            if (og + 1u == (tg + 1u) * nx) xb_add(&bar[XB_TOPGEN], 1u);
            else XB_SPIN(xb_ld(&bar[XB_TOPGEN]) == tg, bar);
            __builtin_amdgcn_fence(__ATOMIC_ACQUIRE, "agent");
            xb_add(&bar[XB_XGEN(b.x)], 1u);
            asm volatile("s_waitcnt vmcnt(0)" ::: "memory");
        } else {
            XB_SPIN(xb_ld(&bar[XB_XGEN(b.x)]) == gen, bar);
            __builtin_amdgcn_fence(__ATOMIC_ACQUIRE, "agent");
            asm volatile("s_waitcnt vmcnt(0)" ::: "memory");
        }
    }
    __syncthreads();
}

#ifndef SKIPMASK
#define SKIPMASK 0
#endif
#ifndef XATTN_MFMA
#define XATTN_MFMA 1
#endif
#ifndef GLA_MFMA
#define GLA_MFMA 1
#endif
#ifndef REPMASK
#define REPMASK 0
#endif
#define REP(bit) for (int rep_ = 0; rep_ < ((REPMASK & (bit)) ? 2 : 1); ++rep_)
__device__ __forceinline__ int dest_row(int mode, int n) {
    if (mode == 1) return n < 2304 ? n : (n < 2320 ? n + 256 : n - 16);
    return n;
}
__device__ __forceinline__ void transpose_item(const float* W, int K, int N, bf16* WT, int mode, LAS float* scr, int item, int lane) {
    const int nblk = (N + 31) / 32, kb = item / nblk, nb = item % nblk, k0 = 64 * kb, n0 = 32 * nb;
    const int nn = n0 + (lane & 31);
#pragma unroll 8
    for (int i = 0; i < 32; ++i) { const int kk = 2 * i + (lane >> 5); scr[kk * 33 + (lane & 31)] = (nn < N) ? W[(size_t)(k0 + kk) * N + nn] : 0.f; }
    LDS_WAIT(); asm volatile("" ::: "memory");
    const int c = lane & 7;
#pragma unroll
    for (int j = 0; j < 4; ++j) { const int n = (lane >> 3) + 8 * j; const LAS float* s = scr + (8 * c) * 33 + n;
        v4u o; o.x = pk2(s[0 * 33], s[1 * 33]); o.y = pk2(s[2 * 33], s[3 * 33]); o.z = pk2(s[4 * 33], s[5 * 33]); o.w = pk2(s[6 * 33], s[7 * 33]);
        if (n0 + n < N) *(GAS v4u*)(WT + (size_t)dest_row(mode, n0 + n) * K + k0 + 8 * c) = o; }
    LDS_WAIT(); asm volatile("" ::: "memory");
}

struct Ptrs {
    const float *x, *mem, *gla_w_in, *gla_w_a2, *gla_b_a, *gla_head_g, *gla_w_out, *conv_w_in, *conv_w, *conv_w_out, *w_mem_kv, *ln1_g, *ln1_b, *ffn_w_up, *ffn_conv_w, *ffn_conv_b, *ffn_w_down, *ln2_g, *ln2_b;
    float* xres;
    bf16 *win, *wout, *wup, *wdn, *wmkv, *xn, *proj, *abuf, *memkv, *u, *h, *memb;
    float *gb, *st, *dec;
    bf16 *qd, *ki, *stb;
};
__device__ __forceinline__ const float* gp(const LAS unsigned long long* PT, int k) {
    const unsigned long long v = PT[k];
    const unsigned lo = __builtin_amdgcn_readfirstlane((unsigned)v), hi = __builtin_amdgcn_readfirstlane((unsigned)(v >> 32));
    return (const float*)(const GAS float*)(((unsigned long long)hi << 32) | lo);
}
__device__ __forceinline__ void load_ptrs(Ptrs& P, const LAS unsigned long long* PT, unsigned char* ws_) {
    asm volatile("" ::: "memory");
    unsigned char* ws = (unsigned char*)(GAS unsigned char*)ws_;
    P.x = gp(PT, 0); P.mem = gp(PT, 1); P.gla_w_in = gp(PT, 2); P.gla_w_a2 = gp(PT, 3); P.gla_b_a = gp(PT, 4); P.gla_head_g = gp(PT, 5); P.gla_w_out = gp(PT, 6);
    P.conv_w_in = gp(PT, 7); P.conv_w = gp(PT, 8); P.conv_w_out = gp(PT, 9); P.w_mem_kv = gp(PT, 10); P.ln1_g = gp(PT, 11); P.ln1_b = gp(PT, 12);
    P.ffn_w_up = gp(PT, 13); P.ffn_conv_w = gp(PT, 14); P.ffn_conv_b = gp(PT, 15); P.ffn_w_down = gp(PT, 16); P.ln2_g = gp(PT, 17); P.ln2_b = gp(PT, 18);
    P.xres = (float*)gp(PT, 19);
    P.win = (bf16*)(ws + WS_WIN); P.wout = (bf16*)(ws + WS_WOUT); P.wup = (bf16*)(ws + WS_WUP); P.wdn = (bf16*)(ws + WS_WDN); P.wmkv = (bf16*)(ws + WS_WMKV);
    P.xn = (bf16*)(ws + WS_XN); P.proj = (bf16*)(ws + WS_PROJ); P.abuf = (bf16*)(ws + WS_ABUF); P.memkv = (bf16*)(ws + WS_MEMKV); P.u = (bf16*)(ws + WS_U); P.h = (bf16*)(ws + WS_H); P.memb = (bf16*)(ws + WS_MEMB);
    P.gb = (float*)(ws + WS_GB); P.st = (float*)(ws + WS_ST); P.dec = (float*)(ws + WS_DEC);
    P.qd = (bf16*)(ws + WS_GB); P.ki = (bf16*)(ws + WS_GB + 12 * MiB); P.stb = (bf16*)(ws + WS_ST);
}

__device__ __forceinline__ void ph_convert(const Ptrs& P, int l, LAS unsigned char* lds, int gw, int NGW, int lane, int gtid, int NT) {
    if (SKIPMASK & 2) return;
    LAS float* scr = (LAS float*)(lds + (gw % NWAVES) * 16384);
    const bool gla = (l & 1) == 0; const int j = l >> 1;
    const float* Win = gla ? P.gla_w_in + (size_t)j * D * GLA_IN : P.conv_w_in + (size_t)j * D * CONV_IN; const int Nin = gla ? GLA_IN : CONV_IN;
    const float* Wout = gla ? P.gla_w_out + (size_t)j * D * D : P.conv_w_out + (size_t)j * D * D;
    const float* Wup = P.ffn_w_up + (size_t)l * D * DFF2; const float* Wdn = P.ffn_w_down + (size_t)l * DFF * D; const float* Wmkv = P.w_mem_kv + (size_t)l * D * 512;
    const int I_IN = (D / 64) * ((Nin + 31) / 32), I_OUT = (D / 64) * (D / 32), I_UP = (D / 64) * (DFF2 / 32), I_DN = (DFF / 64) * (D / 32), I_MKV = (D / 64) * (512 / 32);
    const int total = I_IN + I_OUT + I_UP + I_DN + I_MKV;
    for (int it = gw; it < total; it += NGW) {
        int r = it;
        if (r < I_IN) { transpose_item(Win, D, Nin, P.win, gla ? 1 : 0, scr, r, lane); continue; } r -= I_IN;
        if (r < I_OUT) { transpose_item(Wout, D, D, P.wout, 0, scr, r, lane); continue; } r -= I_OUT;
        if (r < I_UP) { transpose_item(Wup, D, DFF2, P.wup, 0, scr, r, lane); continue; } r -= I_UP;
        if (r < I_DN) { transpose_item(Wdn, DFF, D, P.wdn, 0, scr, r, lane); continue; } r -= I_DN;
        transpose_item(Wmkv, D, 512, P.wmkv, 0, scr, r, lane);
    }
    if (gla) { GAS v4u* z = (GAS v4u*)(P.win + (size_t)GLA_IN * D); for (int i = gtid; i < (LDP - GLA_IN) * D * 2 / 16; i += NT) z[i] = (v4u){0u, 0u, 0u, 0u}; }
}

__device__ __forceinline__ void ph_prologue(const Ptrs& P, int gtid, int NT) {
    if (SKIPMASK & 1) return;
    for (int i = gtid; i < M * D / 4; i += NT) { const f32x4 v = ((const GAS f32x4*)P.x)[i]; ((GAS f32x4*)P.xres)[i] = v; v2u w; w.x = pk2(v.x, v.y); w.y = pk2(v.z, v.w); ((GAS v2u*)P.xn)[i] = w; }
    for (int i = gtid; i < MM * D / 4; i += NT) { const f32x4 v = ((const GAS f32x4*)P.mem)[i]; v2u w; w.x = pk2(v.x, v.y); w.y = pk2(v.z, v.w); ((GAS v2u*)P.memb)[i] = w; }
}

__device__ __forceinline__ void ph_ln(const Ptrs& P, const float* g, const float* b, int gw, int NGW, int lane) {
    if (SKIPMASK & 4) return;
    for (int m = gw; m < M; m += NGW) {
        GAS f32x4* xr = (GAS f32x4*)(P.xres + (size_t)m * D) + lane;
        f32x4 v[4]; float s = 0.f;
#pragma unroll
        for (int j = 0; j < 4; ++j) { v[j] = xr[64 * j]; s += (v[j].x + v[j].y) + (v[j].z + v[j].w); }
        const float mean = wave_sum(s) * (1.f / D); float s2 = 0.f;
#pragma unroll
        for (int j = 0; j < 4; ++j) { v[j] = v[j] - mean; s2 += (v[j].x * v[j].x + v[j].y * v[j].y) + (v[j].z * v[j].z + v[j].w * v[j].w); }
        const float rstd = 1.f / sqrtf(wave_sum(s2) * (1.f / D) + LN_EPS);
        GAS v2u* o8 = (GAS v2u*)(P.xn + (size_t)m * D) + lane;
#pragma unroll
        for (int j = 0; j < 4; ++j) { const f32x4 gg = ((const GAS f32x4*)g)[lane + 64 * j], bb = ((const GAS f32x4*)b)[lane + 64 * j];
            const f32x4 o = v[j] * rstd * gg + bb; xr[64 * j] = o; v2u w; w.x = pk2(o.x, o.y); w.y = pk2(o.z, o.w); o8[64 * j] = w; }
    }
}

__device__ __forceinline__ void ph_gla_g(const Ptrs& P, int j, int gtid, int NT) {
    if (SKIPMASK & 8) return;
    for (int idx = gtid; idx < (M / CH) * GDK; idx += NT) {
        const int c = idx % GDK, t0 = (idx / GDK) * CH;
        float w[RANK];
#pragma unroll
        for (int r = 0; r < RANK; ++r) w[r] = P.gla_w_a2[((size_t)j * RANK + r) * GDK + c];
        const float bias = P.gla_b_a[(size_t)j * GDK + c];
        float G = 0.f;
        for (int t = 0; t < CH; ++t) {
            const GAS v4u* gp = (const GAS v4u*)(P.proj + (size_t)(t0 + t) * LDP + PC_GATE);
            const v4u g0 = gp[0], g1 = gp[1];
            float z = bias;
            z += bflo(g0.x) * w[0] + bfhi(g0.x) * w[1] + bflo(g0.y) * w[2] + bfhi(g0.y) * w[3] + bflo(g0.z) * w[4] + bfhi(g0.z) * w[5] + bflo(g0.w) * w[6] + bfhi(g0.w) * w[7];
            z += bflo(g1.x) * w[8] + bfhi(g1.x) * w[9] + bflo(g1.y) * w[10] + bfhi(g1.y) * w[11] + bflo(g1.z) * w[12] + bfhi(g1.z) * w[13] + bflo(g1.w) * w[14] + bfhi(g1.w) * w[15];
            const float ls = fminf(z, 0.f) - log1pf(expf(-fabsf(z)));
            G += ls * (1.0f / 16.0f);
            P.gb[(size_t)(t0 + t) * GDK + c] = G;
        }
    }
}

__device__ __forceinline__ void ph_gla_kv(const Ptrs& P, LAS unsigned char* lds, int tid, int bid, int G) {
    if (SKIPMASK & 16) return;
    LAS float* KE = (LAS float*)lds;
    LAS float* VL = (LAS float*)(lds + 64 * 96 * 4);
    for (int u = bid; u < NUNITS_GLA; u += G) {
        const int b = u / (GH * NCH), h = (u / NCH) % GH, n = u % NCH, t0 = b * SEQ + n * CH;
        for (int e = tid; e < CH * GHK; e += 512) { const int t = e / GHK, i = e % GHK;
            const float g = P.gb[(size_t)(t0 + t) * GDK + h * GHK + i], gl = P.gb[(size_t)(t0 + CH - 1) * GDK + h * GHK + i];
            KE[e] = bf2f(P.proj[(size_t)(t0 + t) * LDP + PC_K + h * GHK + i]) * expf(gl - g); }
        for (int e = tid; e < CH * GHV; e += 512) { const int t = e / GHV, v = e % GHV; VL[e] = bf2f(P.proj[(size_t)(t0 + t) * LDP + PC_V + h * GHV + v]); }
        if (tid < GHK) P.dec[(size_t)u * GHK + tid] = expf(P.gb[(size_t)(t0 + CH - 1) * GDK + h * GHK + tid]);
        __syncthreads();
        const int vb = tid & 31, ib = tid >> 5;
        float acc[6][6];
#pragma unroll
        for (int a = 0; a < 6; ++a)
#pragma unroll
            for (int c = 0; c < 6; ++c) acc[a][c] = 0.f;
        for (int t = 0; t < CH; ++t) {
            float vv[6], kk[6];
#pragma unroll
            for (int a = 0; a < 6; ++a) vv[a] = VL[t * GHV + vb + 32 * a];
#pragma unroll
            for (int c = 0; c < 6; ++c) kk[c] = KE[t * GHK + ib * 6 + c];
#pragma unroll
            for (int a = 0; a < 6; ++a)
#pragma unroll
                for (int c = 0; c < 6; ++c) acc[a][c] += vv[a] * kk[c];
        }
        float* so = P.st + (size_t)u * (GHV * GHK);
#pragma unroll
        for (int a = 0; a < 6; ++a)
#pragma unroll
            for (int c = 0; c < 6; ++c) so[(vb + 32 * a) * GHK + ib * 6 + c] = acc[a][c];
        __syncthreads();
    }
}

__device__ __forceinline__ void ph_gla_scan(const Ptrs& P, int gtid, int NT) {
    if (SKIPMASK & 32) return;
    constexpr int E = GHV * GHK;
    for (int idx = gtid; idx < BATCH * GH * E; idx += NT) {
        const int e = idx % E, bh = idx / E, i = e % GHK;
        float S = 0.f;
        for (int n = 0; n < NCH; ++n) { const size_t off = (size_t)(bh * NCH + n) * E + e; const float kvv = P.st[off]; P.st[off] = S; S = P.dec[(size_t)(bh * NCH + n) * GHK + i] * S + kvv; }
    }
}

__device__ __forceinline__ void ph_gla_out(const Ptrs& P, int j, LAS unsigned char* lds, int tid, int bid, int G) {
    if (SKIPMASK & 64) return;
    LAS float* QD = (LAS float*)lds;
    LAS float* KI = (LAS float*)(lds + 64 * 97 * 4);
    LAS float* AT = (LAS float*)(lds + 2 * 64 * 97 * 4);
    LAS float* VL = (LAS float*)(lds + 2 * 64 * 97 * 4 + 64 * 65 * 4);
    const int lane = tid & 63, wave = tid >> 6;
    const float scale = 0.10206207261596577f;
    for (int u = bid; u < NUNITS_GLA; u += G) {
        const int b = u / (GH * NCH), h = (u / NCH) % GH, n = u % NCH, t0 = b * SEQ + n * CH;
        for (int e = tid; e < CH * GHK; e += 512) { const int t = e / GHK, i = e % GHK;
            const float g = P.gb[(size_t)(t0 + t) * GDK + h * GHK + i];
            const float q = bf2f(P.proj[(size_t)(t0 + t) * LDP + PC_Q + h * GHK + i]), k = bf2f(P.proj[(size_t)(t0 + t) * LDP + PC_K + h * GHK + i]);
            QD[t * 97 + i] = q * scale * expf(g); KI[t * 97 + i] = k * expf(-g); }
        for (int e = tid; e < CH * GHV; e += 512) { const int t = e / GHV, v = e % GHV; VL[e] = bf2f(P.proj[(size_t)(t0 + t) * LDP + PC_V + h * GHV + v]); }
        __syncthreads();
        {
            float a[8];
#pragma unroll
            for (int r = 0; r < 8; ++r) a[r] = 0.f;
            for (int k = 0; k < GHK; ++k) { const float kv = KI[lane * 97 + k];
#pragma unroll
                for (int r = 0; r < 8; ++r) a[r] += QD[(wave * 8 + r) * 97 + k] * kv; }
#pragma unroll
            for (int r = 0; r < 8; ++r) AT[(wave * 8 + r) * 65 + lane] = (lane <= wave * 8 + r) ? a[r] : 0.f;
        }
        __syncthreads();
        float o[8][3];
#pragma unroll
        for (int r = 0; r < 8; ++r)
#pragma unroll
            for (int a = 0; a < 3; ++a) o[r][a] = 0.f;
        for (int jj = 0; jj < CH; ++jj) { float vv[3];
#pragma unroll
            for (int a = 0; a < 3; ++a) vv[a] = VL[jj * GHV + lane + 64 * a];
#pragma unroll
            for (int r = 0; r < 8; ++r) { const float at = AT[(wave * 8 + r) * 65 + jj];
#pragma unroll
                for (int a = 0; a < 3; ++a) o[r][a] += at * vv[a]; } }
        const float* sp = P.st + (size_t)u * (GHV * GHK);
        for (int k = 0; k < GHK; k += 4) { f32x4 sv[3];
#pragma unroll
            for (int a = 0; a < 3; ++a) sv[a] = *(const GAS f32x4*)(sp + (size_t)(lane + 64 * a) * GHK + k);
#pragma unroll
            for (int r = 0; r < 8; ++r) { const float q0 = QD[(wave * 8 + r) * 97 + k], q1 = QD[(wave * 8 + r) * 97 + k + 1], q2 = QD[(wave * 8 + r) * 97 + k + 2], q3 = QD[(wave * 8 + r) * 97 + k + 3];
#pragma unroll
                for (int a = 0; a < 3; ++a) o[r][a] += q0 * sv[a].x + q1 * sv[a].y + q2 * sv[a].z + q3 * sv[a].w; } }
#pragma unroll
        for (int r = 0; r < 8; ++r) {
            const float ss = wave_sum(o[r][0] * o[r][0] + o[r][1] * o[r][1] + o[r][2] * o[r][2]);
            const float rs = 1.f / sqrtf(ss * (1.f / GHV) + LN_EPS);
            const size_t row = (size_t)(t0 + wave * 8 + r);
#pragma unroll
            for (int a = 0; a < 3; ++a) { const int col = h * GHV + lane + 64 * a;
                const float rr = bf2f(P.proj[row * LDP + PC_R + col]);
                const float val = o[r][a] * rs * P.gla_head_g[(size_t)j * GDV + col] * (rr / (1.f + expf(-rr)));
                P.abuf[row * D + col] = (bf16)f2bf(val); }
        }
        __syncthreads();
    }
}

__device__ __forceinline__ void ph_conv_mix(const Ptrs& P, int j, int gtid, int NT) {
    if (SKIPMASK & 128) return;
    const float* w = P.conv_w + (size_t)j * 3 * MIXW;
    for (int idx = gtid; idx < M * (MIXW / 8); idx += NT) {
        const int cg = idx % (MIXW / 8), t = idx / (MIXW / 8), c0 = cg * 8, pos = t % SEQ;
        float y[8];
#pragma unroll
        for (int e = 0; e < 8; ++e) y[e] = 0.f;
#pragma unroll
        for (int k = 0; k < 3; ++k) {
            if (pos - 2 + k < 0) continue;
            const size_t row = (size_t)(t - 2 + k);
            const v4u cc = *(const GAS v4u*)(P.proj + row * LDP + PC_C + c0), hh = *(const GAS v4u*)(P.proj + row * LDP + PC_H + c0);
            const f32x4 w0 = *(const GAS f32x4*)(w + k * MIXW + c0), w1 = *(const GAS f32x4*)(w + k * MIXW + c0 + 4);
            y[0] += w0.x * (bflo(cc.x) * bflo(hh.x)); y[1] += w0.y * (bfhi(cc.x) * bfhi(hh.x)); y[2] += w0.z * (bflo(cc.y) * bflo(hh.y)); y[3] += w0.w * (bfhi(cc.y) * bfhi(hh.y));
            y[4] += w1.x * (bflo(cc.z) * bflo(hh.z)); y[5] += w1.y * (bfhi(cc.z) * bfhi(hh.z)); y[6] += w1.z * (bflo(cc.w) * bflo(hh.w)); y[7] += w1.w * (bfhi(cc.w) * bfhi(hh.w));
        }
        const v4u bb = *(const GAS v4u*)(P.proj + (size_t)t * LDP + PC_B + c0);
        v4u o; o.x = pk2(bflo(bb.x) * y[0], bfhi(bb.x) * y[1]); o.y = pk2(bflo(bb.y) * y[2], bfhi(bb.y) * y[3]); o.z = pk2(bflo(bb.z) * y[4], bfhi(bb.z) * y[5]); o.w = pk2(bflo(bb.w) * y[6], bfhi(bb.w) * y[7]);
        *(GAS v4u*)(P.abuf + (size_t)t * D + c0) = o;
    }
}

__device__ __forceinline__ void ph_xattn(const Ptrs& P, LAS unsigned char* lds, int tid, int bid, int G) {
    if (SKIPMASK & 256) return;
    LAS float* KL = (LAS float*)lds;
    LAS float* VL = (LAS float*)(lds + 256 * 65 * 4);
    LAS float* PL = (LAS float*)(lds + 256 * 65 * 4 + 256 * 64 * 4);
    LAS float* QL = (LAS float*)(lds + 256 * 65 * 4 + 256 * 64 * 4 + 8 * 256 * 4);
    const int lane = tid & 63, wave = tid >> 6;
    for (int u = bid; u < BATCH * XAH * (SEQ / 256); u += G) {
        const int b = u / (XAH * (SEQ / 256)), h = (u / (SEQ / 256)) % XAH, tb = u % (SEQ / 256);
        for (int e = tid; e < NMEM * XAD; e += 512) { const int m = e / XAD, d = e % XAD; const size_t r = (size_t)(b * NMEM + m) * 512;
            KL[m * 65 + d] = bf2f(P.memkv[r + h * XAD + d]); VL[m * 64 + d] = bf2f(P.memkv[r + 256 + h * XAD + d]); }
        __syncthreads();
        for (int tt = 0; tt < 32; ++tt) {
            const size_t t = (size_t)b * SEQ + tb * 256 + wave * 32 + tt;
            QL[wave * 64 + lane] = bf2f(P.proj[t * LDP + PC_MQ + h * XAD + lane]);
            LDS_WAIT(); asm volatile("" ::: "memory");
            float s[4] = {0.f, 0.f, 0.f, 0.f};
            for (int d = 0; d < XAD; ++d) { const float q = QL[wave * 64 + d];
#pragma unroll
                for (int c = 0; c < 4; ++c) s[c] += q * KL[(lane + 64 * c) * 65 + d]; }
#pragma unroll
            for (int c = 0; c < 4; ++c) s[c] *= 0.125f;
            const float mx = wave_max(fmaxf(fmaxf(s[0], s[1]), fmaxf(s[2], s[3])));
            float p[4], ps = 0.f;
#pragma unroll
            for (int c = 0; c < 4; ++c) { p[c] = expf(s[c] - mx); ps += p[c]; PL[wave * 256 + lane + 64 * c] = p[c]; }
            ps = wave_sum(ps);
            LDS_WAIT(); asm volatile("" ::: "memory");
            float o = 0.f;
            for (int m = 0; m < NMEM; ++m) o += PL[wave * 256 + m] * VL[m * 64 + lane];
            P.abuf[t * D + MIXW + h * XAD + lane] = (bf16)f2bf(o / ps);
            LDS_WAIT(); asm volatile("" ::: "memory");
        }
        __syncthreads();
    }
}


typedef short bf16x8v __attribute__((ext_vector_type(8)));
__device__ __forceinline__ unsigned cvtpk(float lo, float hi) { unsigned r; asm volatile("v_cvt_pk_bf16_f32 %0, %1, %2" : "=v"(r) : "v"(lo), "v"(hi)); return r; }
__device__ __forceinline__ void ph_xattn_mfma(const Ptrs& P, LAS unsigned char* lds, int tid, int bid, int G) {
    constexpr int KST = 144, VST = 528;
    LAS unsigned char* KL = lds;
    LAS unsigned char* VL = lds + 256 * KST;
    const int lane = tid & 63, wave = tid >> 6, fr = lane & 15, fq = lane >> 4;
    for (int u = bid; u < BATCH * XAH * (SEQ / 256); u += G) {
        const int b = u / (XAH * (SEQ / 256)), h = (u / (SEQ / 256)) % XAH, tb = u % (SEQ / 256);
        for (int e = tid; e < NMEM * 8; e += 512) { const int m = e >> 3, c = e & 7; const bf16* src = P.memkv + (size_t)(b * NMEM + m) * 512 + h * XAD + c * 8;
            const v4u kv = *(const GAS v4u*)src, vv = *(const GAS v4u*)(src + 256);
            *(LAS v4u*)(KL + m * KST + c * 16) = kv;
            const int slot = (m & ~31) + 8 * ((m >> 2) & 3) + 4 * ((m >> 4) & 1) + (m & 3);
            LAS unsigned short* vd = (LAS unsigned short*)(VL + (c * 8) * VST + slot * 2);
            vd[0 * (VST / 2)] = (unsigned short)(vv.x & 0xffffu); vd[1 * (VST / 2)] = (unsigned short)(vv.x >> 16); vd[2 * (VST / 2)] = (unsigned short)(vv.y & 0xffffu); vd[3 * (VST / 2)] = (unsigned short)(vv.y >> 16);
            vd[4 * (VST / 2)] = (unsigned short)(vv.z & 0xffffu); vd[5 * (VST / 2)] = (unsigned short)(vv.z >> 16); vd[6 * (VST / 2)] = (unsigned short)(vv.w & 0xffffu); vd[7 * (VST / 2)] = (unsigned short)(vv.w >> 16); }
        __syncthreads();
#pragma unroll 1
        for (int pass = 0; pass < 2; ++pass) {
            const size_t t = (size_t)b * SEQ + tb * 256 + wave * 32 + pass * 16 + fr;
            bf16x8v qf[2];
#pragma unroll
            for (int ks = 0; ks < 2; ++ks) qf[ks] = *(const GAS bf16x8v*)(P.proj + t * LDP + PC_MQ + h * XAD + 32 * ks + 8 * fq);
            f32x4 s[16];
#pragma unroll
            for (int tl = 0; tl < 16; ++tl) { s[tl] = (f32x4){0.f, 0.f, 0.f, 0.f};
#pragma unroll
                for (int ks = 0; ks < 2; ++ks) { const bf16x8v a = *(const LAS bf16x8v*)(KL + (16 * tl + fr) * KST + (32 * ks + 8 * fq) * 2); s[tl] = __builtin_amdgcn_mfma_f32_16x16x32_bf16(a, qf[ks], s[tl], 0, 0, 0); } }
            float mx = -3.0e38f;
#pragma unroll
            for (int tl = 0; tl < 16; ++tl) mx = fmaxf(mx, fmaxf(fmaxf(s[tl][0], s[tl][1]), fmaxf(s[tl][2], s[tl][3])));
            mx = fmaxf(mx, __shfl_xor(mx, 16)); mx = fmaxf(mx, __shfl_xor(mx, 32));
            float ps = 0.f;
#pragma unroll
            for (int tl = 0; tl < 16; ++tl)
#pragma unroll
                for (int r = 0; r < 4; ++r) { const float pv = exp2f((s[tl][r] - mx) * 0.18033688011112042f); s[tl][r] = pv; ps += pv; }
            ps += __shfl_xor(ps, 16); ps += __shfl_xor(ps, 32);
            f32x4 o[4];
#pragma unroll
            for (int dt = 0; dt < 4; ++dt) o[dt] = (f32x4){0.f, 0.f, 0.f, 0.f};
#pragma unroll
            for (int ks = 0; ks < 8; ++ks) {
                v4u pw; pw.x = cvtpk(s[2 * ks][0], s[2 * ks][1]); pw.y = cvtpk(s[2 * ks][2], s[2 * ks][3]); pw.z = cvtpk(s[2 * ks + 1][0], s[2 * ks + 1][1]); pw.w = cvtpk(s[2 * ks + 1][2], s[2 * ks + 1][3]);
                const bf16x8v pf = __builtin_bit_cast(bf16x8v, pw);
#pragma unroll
                for (int dt = 0; dt < 4; ++dt) { const bf16x8v a = *(const LAS bf16x8v*)(VL + (16 * dt + fr) * VST + (32 * ks + 8 * fq) * 2); o[dt] = __builtin_amdgcn_mfma_f32_16x16x32_bf16(a, pf, o[dt], 0, 0, 0); }
            }
            const float inv = 1.f / ps;
#pragma unroll
            for (int dt = 0; dt < 4; ++dt) { v2u w; w.x = cvtpk(o[dt][0] * inv, o[dt][1] * inv); w.y = cvtpk(o[dt][2] * inv, o[dt][3] * inv);
                *(GAS v2u*)(P.abuf + t * D + MIXW + h * XAD + 16 * dt + 4 * fq) = w; }
        }
        __syncthreads();
    }
}


__device__ __forceinline__ void ph_gla_a(const Ptrs& P, int j, LAS unsigned char* lds, int tid, int bid, int G) {
    if (SKIPMASK & 2048) return;
    constexpr int RS = 144;
    LAS unsigned char* VT = lds;
    LAS unsigned char* KT = lds + 384 * RS;
    LAS float* GL = (LAS float*)(lds + 2 * 384 * RS);
    LAS float* DL = (LAS float*)(lds + 2 * 384 * RS + 4096);
    const int lane = tid & 63, wave = tid >> 6, fr = lane & 15, fq = lane >> 4;
    const float scale = 0.10206207261596577f;
    for (int u = bid; u < BATCH * NCH; u += G) {
        const size_t t0 = (size_t)u * CH; const int b = u >> 5, n = u & 31;
        for (int e = tid; e < CH * RANK; e += 512) GL[e] = bf2f(P.proj[(t0 + (e >> 4)) * LDP + PC_GATE + (e & 15)]);
        __syncthreads();
        if (tid < GDK) {
            const int c = tid;
            float w[RANK];
#pragma unroll
            for (int r = 0; r < RANK; ++r) w[r] = P.gla_w_a2[((size_t)j * RANK + r) * GDK + c];
            const float bias = P.gla_b_a[(size_t)j * GDK + c];
            const bf16* qp = P.proj + t0 * LDP + PC_Q + c; const bf16* kp = P.proj + t0 * LDP + PC_K + c;
            bf16* qd = P.qd + t0 * GDK + c; bf16* ki = P.ki + t0 * GDK + c;
            float Gc = 0.f; unsigned prevb = 0u;
#pragma unroll 1
            for (int tb = 0; tb < CH; tb += 8) {
                float qv[8], kv[8];
#pragma unroll
                for (int e = 0; e < 8; ++e) { qv[e] = bf2f(qp[(size_t)(tb + e) * LDP]); kv[e] = bf2f(kp[(size_t)(tb + e) * LDP]); }
#pragma unroll
                for (int e = 0; e < 8; ++e) { const int t = tb + e;
                    const f32x4 g0 = *(const LAS f32x4*)(GL + t * 16), g1 = *(const LAS f32x4*)(GL + t * 16 + 4), g2 = *(const LAS f32x4*)(GL + t * 16 + 8), g3 = *(const LAS f32x4*)(GL + t * 16 + 12);
                    float z = bias;
                    z += g0.x * w[0] + g0.y * w[1] + g0.z * w[2] + g0.w * w[3] + g1.x * w[4] + g1.y * w[5] + g1.z * w[6] + g1.w * w[7];
                    z += g2.x * w[8] + g2.y * w[9] + g2.z * w[10] + g2.w * w[11] + g3.x * w[12] + g3.y * w[13] + g3.z * w[14] + g3.w * w[15];
                    const float ls = fminf(z, 0.f) - __logf(1.f + __expf(-fabsf(z)));
                    Gc += ls * (1.0f / 16.0f);
                    const float eg = __expf(Gc), ieg = __expf(-Gc);
                    qd[(size_t)t * GDK] = (bf16)f2bf(qv[e] * scale * eg);
                    const unsigned kb = f2bf(kv[e] * ieg);
                    ki[(size_t)t * GDK] = (bf16)kb;
                    if (e & 1) *(LAS unsigned*)(KT + c * RS + (t >> 1) * 4) = prevb | (kb << 16); else prevb = kb; }
            }
            const float dc = __expf(Gc);
            DL[c] = dc; P.dec[(size_t)u * GDK + c] = dc;
        }
#pragma unroll 1
        for (int hp = 0; hp < 2; ++hp) {
            for (int e = tid; e < CH * 48; e += 512) { const int t = e / 48, c8 = e % 48;
                const v4u vv = *(const GAS v4u*)(P.proj + (t0 + t) * LDP + PC_V + hp * 384 + c8 * 8);
                LAS unsigned short* vd = (LAS unsigned short*)(VT + (c8 * 8) * RS + t * 2);
                vd[0 * (RS / 2)] = (unsigned short)(vv.x & 0xffffu); vd[1 * (RS / 2)] = (unsigned short)(vv.x >> 16); vd[2 * (RS / 2)] = (unsigned short)(vv.y & 0xffffu); vd[3 * (RS / 2)] = (unsigned short)(vv.y >> 16);
                vd[4 * (RS / 2)] = (unsigned short)(vv.z & 0xffffu); vd[5 * (RS / 2)] = (unsigned short)(vv.z >> 16); vd[6 * (RS / 2)] = (unsigned short)(vv.w & 0xffffu); vd[7 * (RS / 2)] = (unsigned short)(vv.w >> 16); }
            __syncthreads();
            const int hl = wave >> 2, head = 2 * hp + hl, vt0 = 3 * (wave & 3);
            f32x4 acc[3][6];
#pragma unroll
            for (int a = 0; a < 3; ++a)
#pragma unroll
                for (int it = 0; it < 6; ++it) acc[a][it] = (f32x4){0.f, 0.f, 0.f, 0.f};
#pragma unroll
            for (int ks = 0; ks < 2; ++ks) {
                bf16x8v bfr[3];
#pragma unroll
                for (int a = 0; a < 3; ++a) bfr[a] = *(const LAS bf16x8v*)(VT + (hl * 192 + 16 * (vt0 + a) + fr) * RS + (32 * ks + 8 * fq) * 2);
#pragma unroll
                for (int it = 0; it < 6; ++it) { const bf16x8v afr = *(const LAS bf16x8v*)(KT + (head * 96 + 16 * it + fr) * RS + (32 * ks + 8 * fq) * 2);
#pragma unroll
                    for (int a = 0; a < 3; ++a) acc[a][it] = __builtin_amdgcn_mfma_f32_16x16x32_bf16(afr, bfr[a], acc[a][it], 0, 0, 0); }
            }
            bf16* so = P.stb + (size_t)((b * GH + head) * NCH + n) * (GHV * GHK);
#pragma unroll
            for (int it = 0; it < 6; ++it) { const f32x4 d = *(const LAS f32x4*)(DL + head * 96 + 16 * it + 4 * fq);
#pragma unroll
                for (int a = 0; a < 3; ++a) { const f32x4 x = acc[a][it] * d; v2u w2; w2.x = cvtpk(x[0], x[1]); w2.y = cvtpk(x[2], x[3]);
                    *(GAS v2u*)(so + (size_t)(16 * (vt0 + a) + fr) * GHK + 16 * it + 4 * fq) = w2; } }
            __syncthreads();
        }
    }
}

__device__ __forceinline__ void ph_gla_scan2(const Ptrs& P, int gtid, int NT) {
    if (SKIPMASK & 4096) return;
    constexpr int E8 = GHV * GHK / 8;
    for (int idx = gtid; idx < BATCH * GH * E8; idx += NT) {
        const int e8 = idx % E8, bh = idx / E8, b = bh >> 2, h = bh & 3, i0 = (e8 % (GHK / 8)) * 8;
        float S[8];
#pragma unroll
        for (int e = 0; e < 8; ++e) S[e] = 0.f;
        GAS v4u* sp = (GAS v4u*)(P.stb + (size_t)bh * NCH * (GHV * GHK) + (size_t)e8 * 8);
        const float* dp = P.dec + (size_t)b * NCH * GDK + h * GHK + i0;
#pragma unroll 1
        for (int n0 = 0; n0 < NCH; n0 += 4) {
            v4u kv[4]; f32x4 d0[4], d1[4];
#pragma unroll
            for (int q = 0; q < 4; ++q) { kv[q] = sp[(size_t)(n0 + q) * (GHV * GHK / 8)]; d0[q] = *(const GAS f32x4*)(dp + (size_t)(n0 + q) * GDK); d1[q] = *(const GAS f32x4*)(dp + (size_t)(n0 + q) * GDK + 4); }
#pragma unroll
            for (int q = 0; q < 4; ++q) {
                v4u o; o.x = cvtpk(S[0], S[1]); o.y = cvtpk(S[2], S[3]); o.z = cvtpk(S[4], S[5]); o.w = cvtpk(S[6], S[7]);
                sp[(size_t)(n0 + q) * (GHV * GHK / 8)] = o;
                S[0] = d0[q].x * S[0] + bflo(kv[q].x); S[1] = d0[q].y * S[1] + bfhi(kv[q].x); S[2] = d0[q].z * S[2] + bflo(kv[q].y); S[3] = d0[q].w * S[3] + bfhi(kv[q].y);
                S[4] = d1[q].x * S[4] + bflo(kv[q].z); S[5] = d1[q].y * S[5] + bfhi(kv[q].z); S[6] = d1[q].z * S[6] + bflo(kv[q].w); S[7] = d1[q].w * S[7] + bfhi(kv[q].w);
            }
        }
    }
}

__device__ __forceinline__ void ph_gla_c(const Ptrs& P, int j, LAS unsigned char* lds, int tid, int bid, int G) {
    if (SKIPMASK & 8192) return;
    constexpr int RS = 144;
    LAS unsigned char* VT = lds;
    const int lane = tid & 63, wave = tid >> 6, fr = lane & 15, fq = lane >> 4;
    for (int u = bid; u < BATCH * NCH; u += G) {
        const size_t t0 = (size_t)u * CH; const int b = u >> 5, n = u & 31;
#pragma unroll 1
        for (int hp = 0; hp < 2; ++hp) {
            for (int e = tid; e < CH * 48; e += 512) { const int t = e / 48, c8 = e % 48;
                const v4u vv = *(const GAS v4u*)(P.proj + (t0 + t) * LDP + PC_V + hp * 384 + c8 * 8);
                const int slot = (t & ~31) + 8 * ((t >> 2) & 3) + 4 * ((t >> 4) & 1) + (t & 3);
                LAS unsigned short* vd = (LAS unsigned short*)(VT + (c8 * 8) * RS + slot * 2);
                vd[0 * (RS / 2)] = (unsigned short)(vv.x & 0xffffu); vd[1 * (RS / 2)] = (unsigned short)(vv.x >> 16); vd[2 * (RS / 2)] = (unsigned short)(vv.y & 0xffffu); vd[3 * (RS / 2)] = (unsigned short)(vv.y >> 16);
                vd[4 * (RS / 2)] = (unsigned short)(vv.z & 0xffffu); vd[5 * (RS / 2)] = (unsigned short)(vv.z >> 16); vd[6 * (RS / 2)] = (unsigned short)(vv.w & 0xffffu); vd[7 * (RS / 2)] = (unsigned short)(vv.w >> 16); }
            __syncthreads();
            const int hl = wave >> 2, head = 2 * hp + hl, it = wave & 3;
            const size_t ti = t0 + 16 * it + fr;
            bf16x8v qf[3];
#pragma unroll
            for (int ks = 0; ks < 3; ++ks) qf[ks] = *(const GAS bf16x8v*)(P.qd + ti * GDK + head * GHK + 32 * ks + 8 * fq);
            f32x4 at[4];
#pragma unroll
            for (int jt = 0; jt < 4; ++jt) { at[jt] = (f32x4){0.f, 0.f, 0.f, 0.f};
                if (jt <= it) {
#pragma unroll
                    for (int ks = 0; ks < 3; ++ks) { const bf16x8v a = *(const GAS bf16x8v*)(P.ki + (t0 + 16 * jt + fr) * GDK + head * GHK + 32 * ks + 8 * fq); at[jt] = __builtin_amdgcn_mfma_f32_16x16x32_bf16(a, qf[ks], at[jt], 0, 0, 0); }
                    if (jt == it) {
#pragma unroll
                        for (int r = 0; r < 4; ++r) at[jt][r] = (4 * fq + r <= fr) ? at[jt][r] : 0.f; }
                } }
            bf16x8v pf[2];
#pragma unroll
            for (int k2 = 0; k2 < 2; ++k2) { v4u pw; pw.x = cvtpk(at[2 * k2][0], at[2 * k2][1]); pw.y = cvtpk(at[2 * k2][2], at[2 * k2][3]); pw.z = cvtpk(at[2 * k2 + 1][0], at[2 * k2 + 1][1]); pw.w = cvtpk(at[2 * k2 + 1][2], at[2 * k2 + 1][3]);
                pf[k2] = __builtin_bit_cast(bf16x8v, pw); }
            const bf16* sp = P.stb + (size_t)((b * GH + head) * NCH + n) * (GHV * GHK);
            f32x4 o[12]; float ss = 0.f;
#pragma unroll
            for (int vt = 0; vt < 12; ++vt) { o[vt] = (f32x4){0.f, 0.f, 0.f, 0.f};
#pragma unroll
                for (int k2 = 0; k2 < 2; ++k2) { const bf16x8v a = *(const LAS bf16x8v*)(VT + (hl * 192 + 16 * vt + fr) * RS + (32 * k2 + 8 * fq) * 2); o[vt] = __builtin_amdgcn_mfma_f32_16x16x32_bf16(a, pf[k2], o[vt], 0, 0, 0); }
#pragma unroll
                for (int ks = 0; ks < 3; ++ks) { const bf16x8v a = *(const GAS bf16x8v*)(sp + (size_t)(16 * vt + fr) * GHK + 32 * ks + 8 * fq); o[vt] = __builtin_amdgcn_mfma_f32_16x16x32_bf16(a, qf[ks], o[vt], 0, 0, 0); }
                ss += (o[vt][0] * o[vt][0] + o[vt][1] * o[vt][1]) + (o[vt][2] * o[vt][2] + o[vt][3] * o[vt][3]); }
            ss += __shfl_xor(ss, 16); ss += __shfl_xor(ss, 32);
            const float rs = 1.f / sqrtf(ss * (1.f / GHV) + LN_EPS);
#pragma unroll
            for (int vt = 0; vt < 12; ++vt) { const int col = head * GHV + 16 * vt + 4 * fq;
                const v2u rr = *(const GAS v2u*)(P.proj + ti * LDP + PC_R + col); const f32x4 hg = *(const GAS f32x4*)(P.gla_head_g + (size_t)j * GDV + col);
                const float r0 = bflo(rr.x), r1 = bfhi(rr.x), r2 = bflo(rr.y), r3 = bfhi(rr.y);
                const float y0 = o[vt][0] * rs * hg.x * (r0 / (1.f + __expf(-r0))), y1 = o[vt][1] * rs * hg.y * (r1 / (1.f + __expf(-r1)));
                const float y2 = o[vt][2] * rs * hg.z * (r2 / (1.f + __expf(-r2))), y3 = o[vt][3] * rs * hg.w * (r3 / (1.f + __expf(-r3)));
                v2u w2; w2.x = cvtpk(y0, y1); w2.y = cvtpk(y2, y3);
                *(GAS v2u*)(P.abuf + ti * D + col) = w2; }
            __syncthreads();
        }
    }
}

__device__ __forceinline__ void ph_convgate(const Ptrs& P, int l, int gtid, int NT) {
    if (SKIPMASK & 512) return;
    const float* w = P.ffn_conv_w + (size_t)l * 3 * DFF2; const float* bs = P.ffn_conv_b + (size_t)l * DFF2;
    for (int idx = gtid; idx < M * (DFF / 8); idx += NT) {
        const int cg = idx % (DFF / 8), t = idx / (DFF / 8), c0 = cg * 8, pos = t % SEQ;
        float yg[8], yv[8];
        { const f32x4 a0 = *(const GAS f32x4*)(bs + c0), a1 = *(const GAS f32x4*)(bs + c0 + 4), b0 = *(const GAS f32x4*)(bs + DFF + c0), b1 = *(const GAS f32x4*)(bs + DFF + c0 + 4);
          yg[0] = a0.x; yg[1] = a0.y; yg[2] = a0.z; yg[3] = a0.w; yg[4] = a1.x; yg[5] = a1.y; yg[6] = a1.z; yg[7] = a1.w;
          yv[0] = b0.x; yv[1] = b0.y; yv[2] = b0.z; yv[3] = b0.w; yv[4] = b1.x; yv[5] = b1.y; yv[6] = b1.z; yv[7] = b1.w; }
#pragma unroll
        for (int k = 0; k < 3; ++k) {
            if (pos - 2 + k < 0) continue;
            const size_t row = (size_t)(t - 2 + k);
            const v4u ug = *(const GAS v4u*)(P.u + row * DFF2 + c0), uv = *(const GAS v4u*)(P.u + row * DFF2 + DFF + c0);
            const f32x4 g0 = *(const GAS f32x4*)(w + k * DFF2 + c0), g1 = *(const GAS f32x4*)(w + k * DFF2 + c0 + 4), v0 = *(const GAS f32x4*)(w + k * DFF2 + DFF + c0), v1 = *(const GAS f32x4*)(w + k * DFF2 + DFF + c0 + 4);
            yg[0] += g0.x * bflo(ug.x); yg[1] += g0.y * bfhi(ug.x); yg[2] += g0.z * bflo(ug.y); yg[3] += g0.w * bfhi(ug.y); yg[4] += g1.x * bflo(ug.z); yg[5] += g1.y * bfhi(ug.z); yg[6] += g1.z * bflo(ug.w); yg[7] += g1.w * bfhi(ug.w);
            yv[0] += v0.x * bflo(uv.x); yv[1] += v0.y * bfhi(uv.x); yv[2] += v0.z * bflo(uv.y); yv[3] += v0.w * bfhi(uv.y); yv[4] += v1.x * bflo(uv.z); yv[5] += v1.y * bfhi(uv.z); yv[6] += v1.z * bflo(uv.w); yv[7] += v1.w * bfhi(uv.w);
        }
        float hv[8];
#pragma unroll
        for (int e = 0; e < 8; ++e) hv[e] = (yg[e] / (1.f + expf(-yg[e]))) * yv[e];
        v4u o; o.x = pk2(hv[0], hv[1]); o.y = pk2(hv[2], hv[3]); o.z = pk2(hv[4], hv[5]); o.w = pk2(hv[6], hv[7]);
        *(GAS v4u*)(P.h + (size_t)t * DFF + c0) = o;
    }
}

constexpr int N_PHASES = 1 + 2 * (GLA_MFMA ? 10 : 11) + 2 * 8;
struct Args { const float* in[19]; float* out; unsigned char* ws; int ph_lo, ph_hi, li, pad; };
__global__ void __launch_bounds__(NWAVES * 64, 2) trunk_fwd(Args args) {
    extern __shared__ __attribute__((aligned(16))) unsigned char lds_raw[];
    LAS unsigned char* lds = (LAS unsigned char*)lds_raw;
    volatile LAS unsigned* MISC = (volatile LAS unsigned*)(lds + MISC_OFF);
    const int G = gridDim.x, NT = G * NWAVES * 64, NGW = G * NWAVES;
    unsigned char* ws = args.ws;
    LAS unsigned long long* PT = (LAS unsigned long long*)(lds + PTAB_OFF);
    if (threadIdx.x == 0) {
        PT[0] = (unsigned long long)args.in[0]; PT[1] = (unsigned long long)args.in[1]; PT[2] = (unsigned long long)args.in[2]; PT[3] = (unsigned long long)args.in[3]; PT[4] = (unsigned long long)args.in[4];
        PT[5] = (unsigned long long)args.in[5]; PT[6] = (unsigned long long)args.in[6]; PT[7] = (unsigned long long)args.in[7]; PT[8] = (unsigned long long)args.in[8]; PT[9] = (unsigned long long)args.in[9];
        PT[10] = (unsigned long long)args.in[10]; PT[11] = (unsigned long long)args.in[11]; PT[12] = (unsigned long long)args.in[12]; PT[13] = (unsigned long long)args.in[13]; PT[14] = (unsigned long long)args.in[14];
        PT[15] = (unsigned long long)args.in[15]; PT[16] = (unsigned long long)args.in[16]; PT[17] = (unsigned long long)args.in[17]; PT[18] = (unsigned long long)args.in[18]; PT[19] = (unsigned long long)args.out;
    }
    if (threadIdx.x < 64) MISC[threadIdx.x] = 0u;
    __syncthreads();
    XcdBarrier bar; bar.bar = (unsigned*)(ws + WS_CTL) + CW_BAR; bar.x = 0; bar.st = nullptr;
#if ONE_LAUNCH
    bar = xcd_barrier_post((unsigned*)(ws + WS_CTL) + CW_BAR, MISC + 8);
#endif
    const int lo = args.ph_lo, hi = args.ph_hi;
    int p = 0;
#if ONE_LAUNCH
#define GRID_BAR() xcd_barrier(bar)
#else
#define GRID_BAR() do {} while (0)
#endif
#define RUN(...) do { if (p >= lo && p < hi) { int tid = threadIdx.x; asm volatile("" : "+v"(tid)); int bid = blockIdx.x; asm volatile("" : "+s"(bid)); \
        const int lane = tid & 63, wave = __builtin_amdgcn_readfirstlane(tid >> 6), gtid = bid * (NWAVES * 64) + tid, gw = bid * NWAVES + wave; (void)lane; (void)gtid; (void)gw; \
        Ptrs P; load_ptrs(P, PT, ws); __VA_ARGS__; if (p + 1 < hi) GRID_BAR(); } ++p; } while (0)

    RUN(ph_prologue(P, gtid, NT); ph_convert(P, 0, lds, gw, NGW, lane, gtid, NT));
    for (int l = 0; l < DEPTH; ++l) {
        const bool gla = (l & 1) == 0; const int j = l >> 1;
        RUN({ pg8::Gemm g{P.xn, P.win, M, gla ? LDP : CONV_IN, D}; pg8::StaticOrder S; S.init(M, gla ? LDP : CONV_IN, G, bid);
              pg8::EpiBf16 E{P.proj, LDP};
              if (!(SKIPMASK & 1024)) pg8::gemm_phase<pg8::EpiBf16, pg8::StaticOrder, true, true>(lds + RING_OFF, g, S, E, tid);
              pg8::Gemm g2{P.memb, P.wmkv, MM, 512, D}; pg8::StaticOrder S2; S2.init(MM, 512, G, bid);
              pg8::EpiBf16 E2{P.memkv, 512};
              if (!(SKIPMASK & 1024)) pg8::gemm_phase<pg8::EpiBf16, pg8::StaticOrder, true, true>(lds + RING_OFF, g2, S2, E2, tid); });
        RUN({ if (gla) { if (GLA_MFMA) { REP(8) ph_gla_a(P, j, lds, tid, bid, G); } else { REP(8) ph_gla_g(P, j, gtid, NT); } } else { REP(128) ph_conv_mix(P, j, gtid, NT); }
              REP(256) { if (XATTN_MFMA) ph_xattn_mfma(P, lds, tid, bid, G); else ph_xattn(P, lds, tid, bid, G); } });
        if (gla) {
            if (!GLA_MFMA) RUN(REP(16) ph_gla_kv(P, lds, tid, bid, G));
            RUN({ if (GLA_MFMA) ph_gla_scan2(P, gtid, NT); else ph_gla_scan(P, gtid, NT); });
            RUN({ if (GLA_MFMA) { REP(64) ph_gla_c(P, j, lds, tid, bid, G); } else { REP(64) ph_gla_out(P, j, lds, tid, bid, G); } });
        }
        RUN({ pg8::Gemm g{P.abuf, P.wout, M, D, D}; pg8::StaticOrder S; S.init(M, D, G, bid);
              pg8::EpiResid E{P.xres, D, DN_ALPHA};
              if (!(SKIPMASK & 1024)) pg8::gemm_phase<pg8::EpiResid, pg8::StaticOrder, true, true>(lds + RING_OFF, g, S, E, tid); });
        RUN(ph_ln(P, P.ln1_g + (size_t)l * D, P.ln1_b + (size_t)l * D, gw, NGW, lane));
        RUN({ pg8::Gemm g{P.xn, P.wup, M, DFF2, D}; pg8::StaticOrder S; S.init(M, DFF2, G, bid);
              pg8::EpiBf16 E{P.u, DFF2};
              if (!(SKIPMASK & 1024)) pg8::gemm_phase<pg8::EpiBf16, pg8::StaticOrder, true, true>(lds + RING_OFF, g, S, E, tid); });
        RUN(REP(512) ph_convgate(P, l, gtid, NT));
        RUN({ pg8::Gemm g{P.h, P.wdn, M, D, DFF}; pg8::StaticOrder S; S.init(M, D, G, bid);
              pg8::EpiResid E{P.xres, D, DN_ALPHA};
              if (!(SKIPMASK & 1024)) pg8::gemm_phase<pg8::EpiResid, pg8::StaticOrder, true, true>(lds + RING_OFF, g, S, E, tid); });
        RUN({ ph_ln(P, P.ln2_g + (size_t)l * D, P.ln2_b + (size_t)l * D, gw, NGW, lane);
              if (l + 1 < DEPTH) { REP(2) ph_convert(P, l + 1, lds, gw, NGW, lane, gtid, NT); } });
    }
#undef RUN
}

extern "C" void kernel_launch(void* const* d_in, const int* in_sizes, int n_in, void* d_out, int out_size, void* d_ws, size_t ws_size, hipStream_t stream) {
    static int grid = 0;
    if (grid == 0) {
        if (n_in != 19 || out_size != M * D || ws_size < WS_END) { fprintf(stderr, "kernel_launch: unexpected shapes: n_in %d out %d ws %zu\n", n_in, out_size, ws_size); grid = -1; return; }
        int dev = 0, cus = 0, per_cu = 0;
        if (hipGetDevice(&dev) != hipSuccess || hipDeviceGetAttribute(&cus, hipDeviceAttributeMultiprocessorCount, dev) != hipSuccess) { grid = -1; return; }
        if (hipFuncSetAttribute((const void*)trunk_fwd, hipFuncAttributeMaxDynamicSharedMemorySize, LDS_BYTES) != hipSuccess) { fprintf(stderr, "kernel_launch: hipFuncSetAttribute failed\n"); grid = -1; return; }
        if (hipOccupancyMaxActiveBlocksPerMultiprocessor(&per_cu, (const void*)trunk_fwd, NWAVES * 64, LDS_BYTES) != hipSuccess || per_cu < 1) { fprintf(stderr, "kernel_launch: occupancy query says %d\n", per_cu); }
        (void)hipGetLastError();
        grid = cus;
    }
    if (grid < 0) return;
    if (hipMemsetAsync((char*)d_ws + WS_CTL, 0, CTL_ZERO_BYTES, stream) != hipSuccess) return;
    Args a{};
    for (int i = 0; i < 19; ++i) a.in[i] = (const float*)d_in[i];
    a.out = (float*)d_out; a.ws = (unsigned char*)d_ws;
#if ONE_LAUNCH
    a.ph_lo = 0; a.ph_hi = N_PHASES; a.li = 0;
    hipLaunchKernelGGL(trunk_fwd, dim3(grid), dim3(NWAVES * 64), LDS_BYTES, stream, a);
#else
    for (int p = 0; p < N_PHASES; ++p) { a.ph_lo = p; a.ph_hi = p + 1; a.li = p; hipLaunchKernelGGL(trunk_fwd, dim3(grid), dim3(NWAVES * 64), LDS_BYTES, stream, a); }
#endif
}
```

```cpp
#include <hip/hip_runtime.h>
#include <cstdio>
#include <cstdint>

#ifndef ONE_LAUNCH
#define ONE_LAUNCH 1
#endif

namespace pg8 {
#define PG8_LAS __attribute__((address_space(3)))
typedef unsigned short bf16_t;
typedef short bf16x8 __attribute__((ext_vector_type(8)));
typedef float f32x4 __attribute__((ext_vector_type(4)));
typedef unsigned u32x4 __attribute__((ext_vector_type(4)));
constexpr int BM = 256, BK = 64, HALF = 128, HTB = HALF * BK * 2  , STAGE_BYTES = 8 * HTB, NXCD = 8, WGM = 8;

__host__ __device__ __forceinline__ int lds_byte(int r, int c) { const int st = (r >> 4) * 2 + (c >> 5), rr = r & 15, cc = c & 31, ob = rr * 64 + cc * 2; return st * 1024 + (ob ^ (((ob >> 9) & 1) << 5)); }
__host__ __device__ __forceinline__ void stage_rc(int b, int& R, int& C) { const int st = b / 1024, sb = b % 1024, swz = sb ^ (((sb >> 9) & 1) << 5); R = (st >> 1) * 16 + swz / 64; C = (st & 1) * 32 + (swz % 64) / 2; }
__host__ __device__ __forceinline__ int perm32(int rho) { const int n = rho >> 4, i = rho & 15; return 8 * (i >> 2) + 4 * n + (i & 3); }

struct Unit { int pm, pn; };
struct Gemm { const bf16_t* A; const bf16_t* Bt; int M, N, K; };

struct StaticOrder {
    int nM, nN, nwg, G, c;
    __host__ __device__ void init(int M, int N, int G_, int c_) { nM = M / BM; nN = N / BM; nwg = nM * nN; G = G_; c = c_; }
    __host__ __device__ void init_tiles(int nM_, int nN_, int G_, int c_) { nM = nM_; nN = nN_; nwg = nM * nN; G = G_; c = c_; }
    __host__ __device__ bool next(int i, Unit& u) const {
        const long L = (long)i * G + c; if (L >= nwg) return false;
        int wgid = (int)L; { const int q = nwg / NXCD, r = nwg % NXCD, xcd = wgid % NXCD, off = wgid / NXCD; wgid = (xcd < r ? xcd * (q + 1) : r * (q + 1) + (xcd - r) * q) + off; }
        const int nig = WGM * nN, gid = wgid / nig, fm = gid * WGM, gsz = (nM - fm) < WGM ? (nM - fm) : WGM;
        u.pm = fm + ((wgid % nig) % gsz); u.pn = (wgid % nig) / gsz; return true;
    }
    __device__ __forceinline__ void a_ready(const Unit&) const {}
    __device__ __forceinline__ void done(const Unit&) const {}
};


__device__ __forceinline__ unsigned cvt_pk_bf16(float lo, float hi) { unsigned r; asm volatile("v_cvt_pk_bf16_f32 %0, %1, %2" : "=v"(r) : "v"(lo), "v"(hi)); return r; }

struct EpiBf16 {
    static constexpr bool PERM = true, AFTER_DRAIN = false;
    bf16_t* O; int ldc;
    __device__ __forceinline__ void operator()(const f32x4 (&acc)[2][2][4][2], const Unit& u, int wr, int wc, int fr, int fq) const {
        const int row0 = u.pm * BM + wr * 64 + fr; const int col0 = u.pn * BM + wc * 32 + 8 * fq;
#pragma unroll
        for (int ai = 0; ai < 2; ++ai)
#pragma unroll
            for (int m = 0; m < 4; ++m) { bf16_t* rowp = O + (size_t)(row0 + ai * HALF + m * 16) * ldc + col0;
#pragma unroll
                for (int bj = 0; bj < 2; ++bj) { const f32x4 v0 = acc[ai][bj][m][0], v1 = acc[ai][bj][m][1];
                    u32x4 w; w.x = cvt_pk_bf16(v0[0], v0[1]); w.y = cvt_pk_bf16(v0[2], v0[3]); w.z = cvt_pk_bf16(v1[0], v1[1]); w.w = cvt_pk_bf16(v1[2], v1[3]);
                    *(u32x4*)(rowp + bj * HALF) = w; } }
    }
};
struct EpiResid {
    static constexpr bool PERM = false, AFTER_DRAIN = false;
    float* X; int ldc; float alpha;
    __device__ __forceinline__ void operator()(const f32x4 (&acc)[2][2][4][2], const Unit& u, int wr, int wc, int fr, int fq) const {
        const int row0 = u.pm * BM + wr * 64 + fr, col0 = u.pn * BM + wc * 32 + 4 * fq;
#pragma unroll
        for (int ai = 0; ai < 2; ++ai)
#pragma unroll
            for (int m = 0; m < 4; ++m) { float* rowp = X + (size_t)(row0 + ai * HALF + m * 16) * ldc + col0;
#pragma unroll
                for (int bj = 0; bj < 2; ++bj)
#pragma unroll
                    for (int n = 0; n < 2; ++n) { f32x4* p = (f32x4*)(rowp + bj * HALF + n * 16); const f32x4 o = *p; *p = o * alpha + acc[ai][bj][m][n]; } }
    }
};


__device__ __forceinline__ float dpp_shr1(float x) { return __builtin_bit_cast(float, __builtin_amdgcn_update_dpp(0, __builtin_bit_cast(int, x), 0x111, 0xf, 0xf, false)); }
__device__ __forceinline__ f32x4 dpp_shr1v(f32x4 x) { f32x4 r; r[0] = dpp_shr1(x[0]); r[1] = dpp_shr1(x[1]); r[2] = dpp_shr1(x[2]); r[3] = dpp_shr1(x[3]); return r; }
__device__ __forceinline__ f32x4 silu_mul(f32x4 g, f32x4 v) {
    f32x4 r;
#pragma unroll
    for (int e = 0; e < 4; ++e) r[e] = g[e] * __builtin_amdgcn_rcpf(1.0f + __builtin_amdgcn_exp2f(g[e] * -1.4426950408889634f)) * v[e];
    return r;
}
struct EpiConvGate {
    static constexpr bool PERM = true, AFTER_DRAIN = false;
    bf16_t* H; const float* cw; const float* cb; int ntok;
    __device__ __forceinline__ void operator()(const f32x4 (&acc)[2][2][4][2], const Unit& u, int wr, int wc, int fr, int fq) const {
        const int c0 = u.pn * 128 + wc * 32 + 8 * fq;
        const int tbase = 252 * u.pm - 2 + 126 * wr + 8 * fr;
        u32x4 hw[8];
#pragma unroll
        for (int n = 0; n < 2; ++n) {
            const float* wp = cw + c0 + 4 * n; const float* bp = cb + c0 + 4 * n;
            const f32x4 wg0 = *(const f32x4*)(wp), wg1 = *(const f32x4*)(wp + 5632), wg2 = *(const f32x4*)(wp + 2 * 5632);
            const f32x4 wv0 = *(const f32x4*)(wp + 2816), wv1 = *(const f32x4*)(wp + 5632 + 2816), wv2 = *(const f32x4*)(wp + 2 * 5632 + 2816);
            const f32x4 bg = *(const f32x4*)(bp), bv = *(const f32x4*)(bp + 2816);
            const f32x4 gm1 = dpp_shr1v(acc[1][0][3][n]), gm2 = dpp_shr1v(acc[1][0][2][n]), vm1 = dpp_shr1v(acc[1][1][3][n]), vm2 = dpp_shr1v(acc[1][1][2][n]);
            const f32x4 zero = (f32x4){0.f, 0.f, 0.f, 0.f};
#pragma unroll
            for (int j = 0; j < 8; ++j) {
                const f32x4 g0 = acc[j >> 2][0][j & 3][n], v0 = acc[j >> 2][1][j & 3][n];
                f32x4 g1 = (j >= 1) ? acc[(j - 1 + 8) % 8 >> 2][0][(j - 1 + 8) % 8 & 3][n] : gm1, v1 = (j >= 1) ? acc[(j - 1 + 8) % 8 >> 2][1][(j - 1 + 8) % 8 & 3][n] : vm1;
                f32x4 g2 = (j >= 2) ? acc[(j - 2 + 8) % 8 >> 2][0][(j - 2 + 8) % 8 & 3][n] : (j == 1 ? gm1 : gm2), v2 = (j >= 2) ? acc[(j - 2 + 8) % 8 >> 2][1][(j - 2 + 8) % 8 & 3][n] : (j == 1 ? vm1 : vm2);
                const int pos = (tbase + j) & 2047;
                if (pos == 0) { g1 = zero; v1 = zero; }
                if (pos <= 1) { g2 = zero; v2 = zero; }
                const f32x4 yg = wg0 * g2 + wg1 * g1 + wg2 * g0 + bg, yv = wv0 * v2 + wv1 * v1 + wv2 * v0 + bv;
                const f32x4 hh = silu_mul(yg, yv);
                if (n == 0) { hw[j].x = cvt_pk_bf16(hh[0], hh[1]); hw[j].y = cvt_pk_bf16(hh[2], hh[3]); } else { hw[j].z = cvt_pk_bf16(hh[0], hh[1]); hw[j].w = cvt_pk_bf16(hh[2], hh[3]); }
            }
        }
#pragma unroll
        for (int j = 0; j < 8; ++j) { const int t = tbase + j;
            if ((8 * fr + j >= 2) && t < ntok) *(u32x4*)(H + (size_t)t * 2816 + c0) = hw[j]; }
    }
};
template <class Epi, class Sched, bool ALIGN_EPI = false, bool SP2 = false, int AMAP = 0>
__device__ __forceinline__ void gemm_phase(PG8_LAS unsigned char* lds, const Gemm g, const Sched& S, const Epi& E, const int tid) {
    const int wid = __builtin_amdgcn_readfirstlane(tid >> 6), lane = tid & 63, wr = wid >> 2, wc = wid & 3, fr = lane & 15, fq = lane >> 4;
    const int K = g.K, nt = K / BK;
    unsigned voffA[2], voffB[2];
#pragma unroll
    for (int i = 0; i < 2; ++i) { int R, C; stage_rc(tid * 16 + i * 8192, R, C); const int Rb = Epi::PERM ? ((R & ~31) + perm32(R & 31)) : R;
        const int Ra = (AMAP == 1) ? (126 * (R >> 6) + 8 * (R & 15) + ((R >> 4) & 3)) : R;
        voffA[i] = (unsigned)(Ra * K + C) * 2u; voffB[i] = (unsigned)(Rb * K + C) * 2u; }
    const size_t kstep = (size_t)(BK * 2);
    const size_t hstep = (size_t)HALF * K * 2;
    const size_t tstep = 2 * hstep;
    const size_t hstepA = (AMAP == 1) ? (size_t)4 * K * 2 : hstep, tstepA = (AMAP == 1) ? (size_t)252 * K * 2 : tstep;
    const unsigned ldsw = (unsigned)wid * 1024u;
    const int aoff = lds_byte(wr * 64 + fr, fq * 8), boff = lds_byte(wc * 32 + fr, fq * 8);
#define PG8_SA(b, h) (((b) * 2 + (h)) * HTB)
#define PG8_SB(b, h) ((4 + (b) * 2 + (h)) * HTB)
#define PG8_STAGE(bufoff, gbase, voff) do { _Pragma("unroll") for (int _i = 0; _i < 2; ++_i) \
        __builtin_amdgcn_global_load_lds((const unsigned*)((const char*)(gbase) + (voff)[_i]), (PG8_LAS unsigned*)(lds + (bufoff) + ldsw + _i * 8192), 16, 0, 0); } while (0)
#define PG8_LDA(dst, b, h) do { _Pragma("unroll") for (int m = 0; m < 4; ++m) _Pragma("unroll") for (int k = 0; k < 2; ++k) dst[m][k] = *(const PG8_LAS bf16x8*)(lds + PG8_SA(b, h) + aoff + m * 2048 + k * 1024); } while (0)
#define PG8_LDB(dst, b, h) do { _Pragma("unroll") for (int n = 0; n < 2; ++n) _Pragma("unroll") for (int k = 0; k < 2; ++k) dst[n][k] = *(const PG8_LAS bf16x8*)(lds + PG8_SB(b, h) + boff + n * 2048 + k * 1024); } while (0)
#define PG8_MMA(ai, bj, At, Bt) do { __builtin_amdgcn_s_setprio(1); _Pragma("unroll") for (int m = 0; m < 4; ++m) _Pragma("unroll") for (int n = 0; n < 2; ++n) _Pragma("unroll") for (int k = 0; k < 2; ++k) \
        acc[ai][bj][m][n] = __builtin_amdgcn_mfma_f32_16x16x32_bf16(Bt[n][k], At[m][k], acc[ai][bj][m][n], 0, 0, 0); __builtin_amdgcn_s_setprio(0); } while (0)
#define PG8_WAIT_V(n) asm volatile("s_waitcnt vmcnt(" #n ")" ::: "memory")
#define PG8_WAIT_L(n) asm volatile("s_waitcnt lgkmcnt(" #n ")" ::: "memory")
#define PG8_BAR __builtin_amdgcn_s_barrier()
#define PG8_SCHED __builtin_amdgcn_sched_barrier(0)
    Unit cur, nxt; int ui = 0;
    if (!S.next(0, cur)) return;
    f32x4 acc[2][2][4][2];
#pragma unroll
    for (int a = 0; a < 2; ++a)
#pragma unroll
        for (int b = 0; b < 2; ++b)
#pragma unroll
            for (int m = 0; m < 4; ++m)
#pragma unroll
                for (int n = 0; n < 2; ++n) acc[a][b][m][n] = (f32x4){0.f, 0.f, 0.f, 0.f};
    bf16x8 At[4][2], B0[2][2], B1[2][2];
    const char* cA = (const char*)g.A + (size_t)cur.pm * tstepA; const char* cB = (const char*)g.Bt + (size_t)cur.pn * tstep;
    S.a_ready(cur);
    if constexpr (SP2) {
        PG8_STAGE(PG8_SB(0, 0), cB, voffB); PG8_STAGE(PG8_SB(0, 1), cB + hstep, voffB); PG8_STAGE(PG8_SA(0, 0), cA, voffA); PG8_STAGE(PG8_SA(0, 1), cA + hstepA, voffA);
        if (wr == 1) PG8_BAR;
        PG8_WAIT_V(2); PG8_BAR;
        PG8_STAGE(PG8_SB(1, 0), cB + kstep, voffB); PG8_STAGE(PG8_SA(1, 0), cA + kstep, voffA); PG8_STAGE(PG8_SB(1, 1), cB + hstep + kstep, voffB);
        PG8_WAIT_V(6); PG8_BAR;
    } else {
        PG8_STAGE(PG8_SB(0, 0), cB, voffB); PG8_STAGE(PG8_SA(0, 0), cA, voffA); PG8_STAGE(PG8_SB(0, 1), cB + hstep, voffB); PG8_STAGE(PG8_SA(0, 1), cA + hstepA, voffA);
        if (wr == 1) PG8_BAR;
        PG8_WAIT_V(4); PG8_BAR;
        PG8_STAGE(PG8_SB(1, 0), cB + kstep, voffB); PG8_STAGE(PG8_SA(1, 0), cA + kstep, voffA); PG8_STAGE(PG8_SB(1, 1), cB + hstep + kstep, voffB);
        PG8_WAIT_V(6); PG8_BAR;
    }
    for (;;) {
        const bool has_next = S.next(ui + 1, nxt);
        const char* nA = has_next ? (const char*)g.A + (size_t)nxt.pm * tstepA : cA; const char* nB = has_next ? (const char*)g.Bt + (size_t)nxt.pn * tstep : cB;
        for (int t = 0; t < nt; t += 2) {
            const bool last = (t == nt - 2);
            const char* a1 = cA + (size_t)(t + 1) * kstep;
            const char* a2 = last ? nA : cA + (size_t)(t + 2) * kstep; const char* b2 = last ? nB : cB + (size_t)(t + 2) * kstep;
            const char* a3 = a2 + kstep; const char* b3 = b2 + kstep;
            if (last && has_next) S.a_ready(nxt);
            if constexpr (SP2) {
            PG8_LDB(B0, 0, 0); PG8_LDB(B1, 0, 1); PG8_SCHED; PG8_LDA(At, 0, 0); PG8_STAGE(PG8_SA(1, 1), a1 + hstepA, voffA);
            PG8_WAIT_V(8); PG8_WAIT_L(0); PG8_BAR; PG8_MMA(0, 0, At, B0); PG8_MMA(0, 1, At, B1); PG8_BAR; PG8_SCHED;
            PG8_LDA(At, 0, 1); PG8_STAGE(PG8_SB(0, 0), b2, voffB); PG8_STAGE(PG8_SB(0, 1), b2 + hstep, voffB); PG8_STAGE(PG8_SA(0, 0), a2, voffA);
            PG8_WAIT_V(8); PG8_WAIT_L(0); PG8_BAR; PG8_MMA(1, 0, At, B0); PG8_MMA(1, 1, At, B1); PG8_BAR; PG8_SCHED;
            PG8_LDB(B0, 1, 0); PG8_LDB(B1, 1, 1); PG8_SCHED; PG8_LDA(At, 1, 0); PG8_STAGE(PG8_SA(0, 1), a2 + hstepA, voffA);
            PG8_WAIT_V(8); PG8_WAIT_L(0); PG8_BAR; PG8_MMA(0, 0, At, B0); PG8_MMA(0, 1, At, B1); PG8_BAR; PG8_SCHED;
            PG8_LDA(At, 1, 1); PG8_STAGE(PG8_SB(1, 0), b3, voffB); PG8_STAGE(PG8_SB(1, 1), b3 + hstep, voffB); PG8_STAGE(PG8_SA(1, 0), a3, voffA);
            PG8_WAIT_V(8); PG8_WAIT_L(0); PG8_BAR; PG8_MMA(1, 0, At, B0); PG8_MMA(1, 1, At, B1); PG8_BAR; PG8_SCHED;
            } else {
            PG8_LDB(B0, 0, 0); PG8_SCHED; PG8_LDA(At, 0, 0); PG8_STAGE(PG8_SA(1, 1), a1 + hstepA, voffA);
            PG8_WAIT_L(8); PG8_BAR; PG8_WAIT_L(0); PG8_MMA(0, 0, At, B0); PG8_BAR; PG8_SCHED;
            PG8_LDB(B1, 0, 1); PG8_STAGE(PG8_SB(0, 0), b2, voffB);
            PG8_BAR; PG8_WAIT_L(0); PG8_MMA(0, 1, At, B1); PG8_BAR;
            PG8_LDA(At, 0, 1); PG8_STAGE(PG8_SA(0, 0), a2, voffA);
            PG8_BAR; PG8_WAIT_L(0); PG8_MMA(1, 0, At, B0); PG8_BAR; PG8_SCHED;
            PG8_STAGE(PG8_SB(0, 1), b2 + hstep, voffB);
            PG8_WAIT_V(6); PG8_BAR; PG8_MMA(1, 1, At, B1); PG8_BAR;
            PG8_LDB(B0, 1, 0); PG8_SCHED; PG8_LDA(At, 1, 0); PG8_STAGE(PG8_SA(0, 1), a2 + hstepA, voffA);
            PG8_WAIT_L(8); PG8_BAR; PG8_WAIT_L(0); PG8_MMA(0, 0, At, B0); PG8_BAR; PG8_SCHED;
            PG8_LDB(B1, 1, 1); PG8_STAGE(PG8_SB(1, 0), b3, voffB);
            PG8_BAR; PG8_WAIT_L(0); PG8_MMA(0, 1, At, B1); PG8_BAR;
            PG8_LDA(At, 1, 1); PG8_STAGE(PG8_SA(1, 0), a3, voffA);
            PG8_BAR; PG8_WAIT_L(0); PG8_MMA(1, 0, At, B0); PG8_BAR; PG8_SCHED;
            PG8_STAGE(PG8_SB(1, 1), b3 + hstep, voffB);
            PG8_WAIT_V(6); PG8_BAR; PG8_MMA(1, 1, At, B1); PG8_BAR;
            }
        }
        if constexpr (ALIGN_EPI) { if (wr == 0) PG8_BAR; }
        if constexpr (!Epi::AFTER_DRAIN) { E(acc, cur, wr, wc, fr, fq); S.done(cur); }
        if (!has_next) break;
#pragma unroll
        for (int a = 0; a < 2; ++a)
#pragma unroll
            for (int b = 0; b < 2; ++b)
#pragma unroll
                for (int m = 0; m < 4; ++m)
#pragma unroll
                    for (int n = 0; n < 2; ++n) acc[a][b][m][n] = (f32x4){0.f, 0.f, 0.f, 0.f};
        cur = nxt; cA = nA; cB = nB; ++ui;
        if constexpr (ALIGN_EPI) { if (wr == 1) PG8_BAR; }
    }
    PG8_WAIT_V(0);
    if constexpr (!ALIGN_EPI) { if (wr == 0) PG8_BAR; }
    PG8_BAR;
    if constexpr (Epi::AFTER_DRAIN) { E.fused(acc, cur, wr, wc, fr, fq, lds, wid, lane); S.done(cur); }
#undef PG8_SA
#undef PG8_SB
#undef PG8_STAGE
#undef PG8_LDA
#undef PG8_LDB
#undef PG8_MMA
#undef PG8_WAIT_V
#undef PG8_WAIT_L
#undef PG8_BAR
#undef PG8_SCHED
}
}

constexpr int NWAVES = 8;
constexpr int BATCH = 8, SEQ = 2048, D = 1024, DEPTH = 4;
constexpr int M = BATCH * SEQ;
constexpr int NMEM = 256, MM = BATCH * NMEM;
constexpr int XAW = 256, XAH = 4, XAD = 64, MIXW = 768;
constexpr int GH = 4, GDK = 384, GDV = 768, GHK = 96, GHV = 192, RANK = 16, CH = 64, NCH = SEQ / CH;
constexpr int DFF = 2816, DFF2 = 5632;
constexpr int GLA_IN = 2576, CONV_IN = 2560, LDP = 2816;
constexpr float LN_EPS = 1e-5f;
constexpr float DN_ALPHA = 1.6817928305074292f;
constexpr int PC_Q = 0, PC_K = 384, PC_V = 768, PC_R = 1536, PC_MQ = 2304, PC_GATE = 2560;
constexpr int PC_B = 0, PC_C = 768, PC_H = 1536;
constexpr int NUNITS_GLA = BATCH * GH * NCH;

constexpr size_t MiB = 1u << 20;
constexpr size_t WS_CTL = 0, CTL_ZERO_BYTES = 1 * MiB;
constexpr size_t WS_WIN = 1 * MiB;
constexpr size_t WS_WOUT = WS_WIN + 5 * MiB + MiB / 2;
constexpr size_t WS_WUP = WS_WOUT + 2 * MiB;
constexpr size_t WS_WDN = WS_WUP + 11 * MiB;
constexpr size_t WS_WMKV = WS_WDN + 5 * MiB + MiB / 2;
constexpr size_t WS_XN = 27 * MiB;
constexpr size_t WS_PROJ = 60 * MiB;
constexpr size_t WS_ABUF = 148 * MiB;
constexpr size_t WS_GB = 180 * MiB;
constexpr size_t WS_MEMKV = 204 * MiB;
constexpr size_t WS_U = 60 * MiB;
constexpr size_t WS_H = 236 * MiB;
constexpr size_t WS_ST = 236 * MiB;
constexpr size_t WS_DEC = 308 * MiB;
constexpr size_t WS_MEMB = 324 * MiB;
constexpr size_t WS_END = 328 * MiB;
static_assert(WS_WMKV + 1 * MiB <= WS_XN && WS_U + (size_t)M * DFF2 * 2 <= WS_H && WS_DEC + (size_t)NUNITS_GLA * GHK * 4 <= WS_MEMB, "d_ws map");
constexpr int CW_BAR = 4096;

constexpr int LDS_BYTES = 163840;
constexpr int RING_OFF = 0;
constexpr int MISC_OFF = 163840 - 256;
constexpr int PTAB_OFF = 163840 - 512;

#define GAS __attribute__((address_space(1)))
#define LAS __attribute__((address_space(3)))
typedef unsigned short bf16;
typedef unsigned v4u __attribute__((ext_vector_type(4)));
typedef unsigned v2u __attribute__((ext_vector_type(2)));
typedef float f32x4 __attribute__((ext_vector_type(4)));
typedef GAS unsigned gu32;
#define RLX_AGENT __ATOMIC_RELAXED, __HIP_MEMORY_SCOPE_AGENT
#define LDS_WAIT() asm volatile("s_waitcnt lgkmcnt(0)" ::: "memory")
__device__ __forceinline__ unsigned f2bf(float f) { unsigned u = __builtin_bit_cast(unsigned, f); return (u + 0x7fffu + ((u >> 16) & 1u)) >> 16; }
__device__ __forceinline__ unsigned pk2(float lo, float hi) { return f2bf(lo) | (f2bf(hi) << 16); }
__device__ __forceinline__ float bf2f(unsigned short b) { return __uint_as_float(((unsigned)b) << 16); }
__device__ __forceinline__ float bflo(unsigned w) { return __uint_as_float(w << 16); }
__device__ __forceinline__ float bfhi(unsigned w) { return __uint_as_float(w & 0xffff0000u); }
__device__ __forceinline__ float wave_sum(float v) {
#pragma unroll
    for (int o = 1; o < 64; o <<= 1) v += __shfl_xor(v, o);
    return v;
}
__device__ __forceinline__ float wave_max(float v) {
#pragma unroll
    for (int o = 1; o < 64; o <<= 1) v = fmaxf(v, __shfl_xor(v, o));
    return v;
}
#define XB_TMO      128
#define XB_XCNT(j)  (256  + 64 * (j))
#define XB_XSUB(j)  (1280 + 64 * (j))
#define XB_XGEN(j)  (2304 + 64 * (j))
#define XB_TOP      3328
#define XB_TOPGEN   3392
#define XCD_BAR_WORDS 3456
#define XB_SPIN_CAP (1u << 18)

__device__ __forceinline__ unsigned xb_ld(unsigned* p)              { return __hip_atomic_load(p, __ATOMIC_RELAXED, __HIP_MEMORY_SCOPE_AGENT); }
__device__ __forceinline__ unsigned xb_add(unsigned* p, unsigned v) { return __hip_atomic_fetch_add(p, v, __ATOMIC_RELAXED, __HIP_MEMORY_SCOPE_AGENT); }
__device__ __forceinline__ unsigned xb_xcc_id() { return (unsigned)__builtin_amdgcn_s_getreg((3 << 11) | 20) & 0xFu; }
#define XB_SPIN(cond, bar) do { unsigned _sp = 0; while (cond) { __builtin_amdgcn_s_sleep(1); \
    if ((++_sp & 255u) == 0u) { if (xb_ld(&(bar)[XB_TMO])) break; if (_sp > XB_SPIN_CAP) { atomicAdd(&(bar)[XB_TMO], 1u); break; } } } } while (0)

struct XcdBarrier {
    unsigned* bar; unsigned x;
    volatile LAS unsigned* st;
};

__device__ __forceinline__ XcdBarrier xcd_barrier_post(unsigned* bar, volatile LAS unsigned* st) {
    XcdBarrier b; b.bar = bar; b.x = xb_xcc_id(); b.st = st;
    if (threadIdx.x == 0) (void)xb_add(&bar[XB_XCNT(b.x)], 1u);
    return b;
}
__device__ __forceinline__ void xcd_barrier_complete(unsigned* bar, unsigned x, unsigned& nloc, unsigned& nx) {
    const unsigned G = gridDim.x * gridDim.y * gridDim.z;
    unsigned sum, cnt, mine, sp = 0u;
    for (;;) {
        sum = 0u; cnt = 0u; mine = 0u;
#pragma unroll
        for (unsigned j = 0; j < 16; ++j) { const unsigned c = xb_ld(&bar[XB_XCNT(j)]); sum += c; cnt += (c > 0u) ? 1u : 0u; mine = (j == x) ? c : mine; }
        if (sum == G) break;
        __builtin_amdgcn_s_sleep(1);
        if ((++sp & 255u) == 0u) { if (xb_ld(&bar[XB_TMO])) break; if (sp > XB_SPIN_CAP) { atomicAdd(&bar[XB_TMO], 1u); break; } }
    }
    nloc = mine > 0u ? mine : 1u; nx = cnt > 0u ? cnt : 1u;
}

__device__ __forceinline__ void xcd_barrier(const XcdBarrier& b) {
    asm volatile("s_waitcnt vmcnt(0)" ::: "memory");
    __syncthreads();
    if (threadIdx.x == 0) {
        unsigned* bar = b.bar;
        __builtin_amdgcn_s_waitcnt(0);
        unsigned nloc = b.st[0], nx = b.st[1];
        if (nloc == 0u) { xcd_barrier_complete(bar, b.x, nloc, nx); b.st[0] = nloc; b.st[1] = nx; }
        const unsigned old = xb_add(&bar[XB_XSUB(b.x)], 1u);
        const unsigned gen = old / nloc;
        if (old + 1u == (gen + 1u) * nloc) {
            __builtin_amdgcn_fence(__ATOMIC_RELEASE, "agent");
            asm volatile("s_waitcnt vmcnt(0)" ::: "memory");
            const unsigned og = xb_add(&bar[XB_TOP], 1u);
            const unsigned tg = og / nx;
            if (og + 1u == (tg + 1u) * nx) xb_add(&bar[XB_TOPGEN], 1u);
            else XB_SPIN(xb_ld(&bar[XB_TOPGEN]) == tg, bar);
            __builtin_amdgcn_fence(__ATOMIC_ACQUIRE, "agent");
            xb_add(&bar[XB_XGEN(b.x)], 1u);
            asm volatile("s_waitcnt vmcnt(0)" ::: "memory");
        } else {
            XB_SPIN(xb_ld(&bar[XB_XGEN(b.x)]) == gen, bar);
            __builtin_amdgcn_fence(__ATOMIC_ACQUIRE, "agent");
            asm volatile("s_waitcnt vmcnt(0)" ::: "memory");
        }
    }
    __syncthreads();
}

#ifndef SKIPMASK
#define SKIPMASK 0
#endif
#ifndef XATTN_MFMA
#define XATTN_MFMA 1
#endif
#ifndef GLA_MFMA
#define GLA_MFMA 1
#endif
#ifndef FFN_FUSED
#define FFN_FUSED 1
#endif
#ifndef REPMASK
#define REPMASK 0
#endif
#define REP(bit) for (int rep_ = 0; rep_ < ((REPMASK & (bit)) ? 2 : 1); ++rep_)
__device__ __forceinline__ int dest_row(int mode, int n) {
    if (mode == 1) return n < 2304 ? n : (n < 2320 ? n + 256 : n - 16);
    if (mode == 2) { const int v = n >= DFF ? 1 : 0, c = n - v * DFF; return 256 * (c >> 7) + 128 * v + (c & 127); }
    return n;
}
__device__ __forceinline__ void transpose_item(const float* W, int K, int N, bf16* WT, int mode, LAS float* scr, int item, int lane) {
    const int nblk = (N + 31) / 32, kb = item / nblk, nb = item % nblk, k0 = 64 * kb, n0 = 32 * nb;
    const int nn = n0 + (lane & 31);
#pragma unroll 8
    for (int i = 0; i < 32; ++i) { const int kk = 2 * i + (lane >> 5); scr[kk * 33 + (lane & 31)] = (nn < N) ? W[(size_t)(k0 + kk) * N + nn] : 0.f; }
    LDS_WAIT(); asm volatile("" ::: "memory");
    const int c = lane & 7;
#pragma unroll
    for (int j = 0; j < 4; ++j) { const int n = (lane >> 3) + 8 * j; const LAS float* s = scr + (8 * c) * 33 + n;
        v4u o; o.x = pk2(s[0 * 33], s[1 * 33]); o.y = pk2(s[2 * 33], s[3 * 33]); o.z = pk2(s[4 * 33], s[5 * 33]); o.w = pk2(s[6 * 33], s[7 * 33]);
        if (n0 + n < N) *(GAS v4u*)(WT + (size_t)dest_row(mode, n0 + n) * K + k0 + 8 * c) = o; }
    LDS_WAIT(); asm volatile("" ::: "memory");
}

struct Ptrs {
    const float *x, *mem, *gla_w_in, *gla_w_a2, *gla_b_a, *gla_head_g, *gla_w_out, *conv_w_in, *conv_w, *conv_w_out, *w_mem_kv, *ln1_g, *ln1_b, *ffn_w_up, *ffn_conv_w, *ffn_conv_b, *ffn_w_down, *ln2_g, *ln2_b;
    float* xres;
    bf16 *win, *wout, *wup, *wdn, *wmkv, *xn, *proj, *abuf, *memkv, *u, *h, *memb;
    float *gb, *st, *dec;
    bf16 *qd, *ki, *stb;
};
__device__ __forceinline__ const float* gp(const LAS unsigned long long* PT, int k) {
    const unsigned long long v = PT[k];
    const unsigned lo = __builtin_amdgcn_readfirstlane((unsigned)v), hi = __builtin_amdgcn_readfirstlane((unsigned)(v >> 32));
    return (const float*)(const GAS float*)(((unsigned long long)hi << 32) | lo);
}
__device__ __forceinline__ void load_ptrs(Ptrs& P, const LAS unsigned long long* PT, unsigned char* ws_) {
    asm volatile("" ::: "memory");
    unsigned char* ws = (unsigned char*)(GAS unsigned char*)ws_;
    P.x = gp(PT, 0); P.mem = gp(PT, 1); P.gla_w_in = gp(PT, 2); P.gla_w_a2 = gp(PT, 3); P.gla_b_a = gp(PT, 4); P.gla_head_g = gp(PT, 5); P.gla_w_out = gp(PT, 6);
    P.conv_w_in = gp(PT, 7); P.conv_w = gp(PT, 8); P.conv_w_out = gp(PT, 9); P.w_mem_kv = gp(PT, 10); P.ln1_g = gp(PT, 11); P.ln1_b = gp(PT, 12);
    P.ffn_w_up = gp(PT, 13); P.ffn_conv_w = gp(PT, 14); P.ffn_conv_b = gp(PT, 15); P.ffn_w_down = gp(PT, 16); P.ln2_g = gp(PT, 17); P.ln2_b = gp(PT, 18);
    P.xres = (float*)gp(PT, 19);
    P.win = (bf16*)(ws + WS_WIN); P.wout = (bf16*)(ws + WS_WOUT); P.wup = (bf16*)(ws + WS_WUP); P.wdn = (bf16*)(ws + WS_WDN); P.wmkv = (bf16*)(ws + WS_WMKV);
    P.xn = (bf16*)(ws + WS_XN); P.proj = (bf16*)(ws + WS_PROJ); P.abuf = (bf16*)(ws + WS_ABUF); P.memkv = (bf16*)(ws + WS_MEMKV); P.u = (bf16*)(ws + WS_U); P.h = (bf16*)(ws + WS_H); P.memb = (bf16*)(ws + WS_MEMB);
    P.gb = (float*)(ws + WS_GB); P.st = (float*)(ws + WS_ST); P.dec = (float*)(ws + WS_DEC);
    P.qd = (bf16*)(ws + WS_GB); P.ki = (bf16*)(ws + WS_GB + 12 * MiB); P.stb = (bf16*)(ws + WS_ST);
}

__device__ __forceinline__ void ph_convert(const Ptrs& P, int l, LAS unsigned char* lds, int gw, int NGW, int lane, int gtid, int NT) {
    if (SKIPMASK & 2) return;
    LAS float* scr = (LAS float*)(lds + (gw % NWAVES) * 16384);
    const bool gla = (l & 1) == 0; const int j = l >> 1;
    const float* Win = gla ? P.gla_w_in + (size_t)j * D * GLA_IN : P.conv_w_in + (size_t)j * D * CONV_IN; const int Nin = gla ? GLA_IN : CONV_IN;
    const float* Wout = gla ? P.gla_w_out + (size_t)j * D * D : P.conv_w_out + (size_t)j * D * D;
    const float* Wup = P.ffn_w_up + (size_t)l * D * DFF2; const float* Wdn = P.ffn_w_down + (size_t)l * DFF * D; const float* Wmkv = P.w_mem_kv + (size_t)l * D * 512;
    const int I_IN = (D / 64) * ((Nin + 31) / 32), I_OUT = (D / 64) * (D / 32), I_UP = (D / 64) * (DFF2 / 32), I_DN = (DFF / 64) * (D / 32), I_MKV = (D / 64) * (512 / 32);
    const int total = I_IN + I_OUT + I_UP + I_DN + I_MKV;
    for (int it = gw; it < total; it += NGW) {
        int r = it;
        if (r < I_IN) { transpose_item(Win, D, Nin, P.win, gla ? 1 : 0, scr, r, lane); continue; } r -= I_IN;
        if (r < I_OUT) { transpose_item(Wout, D, D, P.wout, 0, scr, r, lane); continue; } r -= I_OUT;
        if (r < I_UP) { transpose_item(Wup, D, DFF2, P.wup, FFN_FUSED ? 2 : 0, scr, r, lane); continue; } r -= I_UP;
        if (r < I_DN) { transpose_item(Wdn, DFF, D, P.wdn, 0, scr, r, lane); continue; } r -= I_DN;
        transpose_item(Wmkv, D, 512, P.wmkv, 0, scr, r, lane);
    }
    if (gla) { GAS v4u* z = (GAS v4u*)(P.win + (size_t)GLA_IN * D); for (int i = gtid; i < (LDP - GLA_IN) * D * 2 / 16; i += NT) z[i] = (v4u){0u, 0u, 0u, 0u}; }
}

__device__ __forceinline__ void ph_prologue(const Ptrs& P, int gtid, int NT) {
    if (SKIPMASK & 1) return;
    for (int i = gtid; i < M * D / 4; i += NT) { const f32x4 v = ((const GAS f32x4*)P.x)[i]; ((GAS f32x4*)P.xres)[i] = v; v2u w; w.x = pk2(v.x, v.y); w.y = pk2(v.z, v.w); ((GAS v2u*)P.xn)[i] = w; }
    for (int i = gtid; i < MM * D / 4; i += NT) { const f32x4 v = ((const GAS f32x4*)P.mem)[i]; v2u w; w.x = pk2(v.x, v.y); w.y = pk2(v.z, v.w); ((GAS v2u*)P.memb)[i] = w; }
}

__device__ __forceinline__ void ph_ln(const Ptrs& P, const float* g, const float* b, int gw, int NGW, int lane) {
    if (SKIPMASK & 4) return;
    for (int m = gw; m < M; m += NGW) {
        GAS f32x4* xr = (GAS f32x4*)(P.xres + (size_t)m * D) + lane;
        f32x4 v[4]; float s = 0.f;
#pragma unroll
        for (int j = 0; j < 4; ++j) { v[j] = xr[64 * j]; s += (v[j].x + v[j].y) + (v[j].z + v[j].w); }
        const float mean = wave_sum(s) * (1.f / D); float s2 = 0.f;
#pragma unroll
        for (int j = 0; j < 4; ++j) { v[j] = v[j] - mean; s2 += (v[j].x * v[j].x + v[j].y * v[j].y) + (v[j].z * v[j].z + v[j].w * v[j].w); }
        const float rstd = 1.f / sqrtf(wave_sum(s2) * (1.f / D) + LN_EPS);
        GAS v2u* o8 = (GAS v2u*)(P.xn + (size_t)m * D) + lane;
#pragma unroll
        for (int j = 0; j < 4; ++j) { const f32x4 gg = ((const GAS f32x4*)g)[lane + 64 * j], bb = ((const GAS f32x4*)b)[lane + 64 * j];
            const f32x4 o = v[j] * rstd * gg + bb; xr[64 * j] = o; v2u w; w.x = pk2(o.x, o.y); w.y = pk2(o.z, o.w); o8[64 * j] = w; }
    }
}

__device__ __forceinline__ void ph_gla_g(const Ptrs& P, int j, int gtid, int NT) {
    if (SKIPMASK & 8) return;
    for (int idx = gtid; idx < (M / CH) * GDK; idx += NT) {
        const int c = idx % GDK, t0 = (idx / GDK) * CH;
        float w[RANK];
#pragma unroll
        for (int r = 0; r < RANK; ++r) w[r] = P.gla_w_a2[((size_t)j * RANK + r) * GDK + c];
        const float bias = P.gla_b_a[(size_t)j * GDK + c];
        float G = 0.f;
        for (int t = 0; t < CH; ++t) {
            const GAS v4u* gp = (const GAS v4u*)(P.proj + (size_t)(t0 + t) * LDP + PC_GATE);
            const v4u g0 = gp[0], g1 = gp[1];
            float z = bias;
            z += bflo(g0.x) * w[0] + bfhi(g0.x) * w[1] + bflo(g0.y) * w[2] + bfhi(g0.y) * w[3] + bflo(g0.z) * w[4] + bfhi(g0.z) * w[5] + bflo(g0.w) * w[6] + bfhi(g0.w) * w[7];
            z += bflo(g1.x) * w[8] + bfhi(g1.x) * w[9] + bflo(g1.y) * w[10] + bfhi(g1.y) * w[11] + bflo(g1.z) * w[12] + bfhi(g1.z) * w[13] + bflo(g1.w) * w[14] + bfhi(g1.w) * w[15];
            const float ls = fminf(z, 0.f) - log1pf(expf(-fabsf(z)));
            G += ls * (1.0f / 16.0f);
            P.gb[(size_t)(t0 + t) * GDK + c] = G;
        }
    }
}

__device__ __forceinline__ void ph_gla_kv(const Ptrs& P, LAS unsigned char* lds, int tid, int bid, int G) {
    if (SKIPMASK & 16) return;
    LAS float* KE = (LAS float*)lds;
    LAS float* VL = (LAS float*)(lds + 64 * 96 * 4);
    for (int u = bid; u < NUNITS_GLA; u += G) {
        const int b = u / (GH * NCH), h = (u / NCH) % GH, n = u % NCH, t0 = b * SEQ + n * CH;
        for (int e = tid; e < CH * GHK; e += 512) { const int t = e / GHK, i = e % GHK;
            const float g = P.gb[(size_t)(t0 + t) * GDK + h * GHK + i], gl = P.gb[(size_t)(t0 + CH - 1) * GDK + h * GHK + i];
            KE[e] = bf2f(P.proj[(size_t)(t0 + t) * LDP + PC_K + h * GHK + i]) * expf(gl - g); }
        for (int e = tid; e < CH * GHV; e += 512) { const int t = e / GHV, v = e % GHV; VL[e] = bf2f(P.proj[(size_t)(t0 + t) * LDP + PC_V + h * GHV + v]); }
        if (tid < GHK) P.dec[(size_t)u * GHK + tid] = expf(P.gb[(size_t)(t0 + CH - 1) * GDK + h * GHK + tid]);
        __syncthreads();
        const int vb = tid & 31, ib = tid >> 5;
        float acc[6][6];
#pragma unroll
        for (int a = 0; a < 6; ++a)
#pragma unroll
            for (int c = 0; c < 6; ++c) acc[a][c] = 0.f;
        for (int t = 0; t < CH; ++t) {
            float vv[6], kk[6];
#pragma unroll
            for (int a = 0; a < 6; ++a) vv[a] = VL[t * GHV + vb + 32 * a];
#pragma unroll
            for (int c = 0; c < 6; ++c) kk[c] = KE[t * GHK + ib * 6 + c];
#pragma unroll
            for (int a = 0; a < 6; ++a)
#pragma unroll
                for (int c = 0; c < 6; ++c) acc[a][c] += vv[a] * kk[c];
        }
        float* so = P.st + (size_t)u * (GHV * GHK);
#pragma unroll
        for (int a = 0; a < 6; ++a)
#pragma unroll
            for (int c = 0; c < 6; ++c) so[(vb + 32 * a) * GHK + ib * 6 + c] = acc[a][c];
        __syncthreads();
    }
}

__device__ __forceinline__ void ph_gla_scan(const Ptrs& P, int gtid, int NT) {
    if (SKIPMASK & 32) return;
    constexpr int E = GHV * GHK;
    for (int idx = gtid; idx < BATCH * GH * E; idx += NT) {
        const int e = idx % E, bh = idx / E, i = e % GHK;
        float S = 0.f;
        for (int n = 0; n < NCH; ++n) { const size_t off = (size_t)(bh * NCH + n) * E + e; const float kvv = P.st[off]; P.st[off] = S; S = P.dec[(size_t)(bh * NCH + n) * GHK + i] * S + kvv; }
    }
}

__device__ __forceinline__ void ph_gla_out(const Ptrs& P, int j, LAS unsigned char* lds, int tid, int bid, int G) {
    if (SKIPMASK & 64) return;
    LAS float* QD = (LAS float*)lds;
    LAS float* KI = (LAS float*)(lds + 64 * 97 * 4);
    LAS float* AT = (LAS float*)(lds + 2 * 64 * 97 * 4);
    LAS float* VL = (LAS float*)(lds + 2 * 64 * 97 * 4 + 64 * 65 * 4);
    const int lane = tid & 63, wave = tid >> 6;
    const float scale = 0.10206207261596577f;
    for (int u = bid; u < NUNITS_GLA; u += G) {
        const int b = u / (GH * NCH), h = (u / NCH) % GH, n = u % NCH, t0 = b * SEQ + n * CH;
        for (int e = tid; e < CH * GHK; e += 512) { const int t = e / GHK, i = e % GHK;
            const float g = P.gb[(size_t)(t0 + t) * GDK + h * GHK + i];
            const float q = bf2f(P.proj[(size_t)(t0 + t) * LDP + PC_Q + h * GHK + i]), k = bf2f(P.proj[(size_t)(t0 + t) * LDP + PC_K + h * GHK + i]);
            QD[t * 97 + i] = q * scale * expf(g); KI[t * 97 + i] = k * expf(-g); }
        for (int e = tid; e < CH * GHV; e += 512) { const int t = e / GHV, v = e % GHV; VL[e] = bf2f(P.proj[(size_t)(t0 + t) * LDP + PC_V + h * GHV + v]); }
        __syncthreads();
        {
            float a[8];
#pragma unroll
            for (int r = 0; r < 8; ++r) a[r] = 0.f;
            for (int k = 0; k < GHK; ++k) { const float kv = KI[lane * 97 + k];
#pragma unroll
                for (int r = 0; r < 8; ++r) a[r] += QD[(wave * 8 + r) * 97 + k] * kv; }
#pragma unroll
            for (int r = 0; r < 8; ++r) AT[(wave * 8 + r) * 65 + lane] = (lane <= wave * 8 + r) ? a[r] : 0.f;
        }
        __syncthreads();
        float o[8][3];
#pragma unroll
        for (int r = 0; r < 8; ++r)
#pragma unroll
            for (int a = 0; a < 3; ++a) o[r][a] = 0.f;
        for (int jj = 0; jj < CH; ++jj) { float vv[3];
#pragma unroll
            for (int a = 0; a < 3; ++a) vv[a] = VL[jj * GHV + lane + 64 * a];
#pragma unroll
            for (int r = 0; r < 8; ++r) { const float at = AT[(wave * 8 + r) * 65 + jj];
#pragma unroll
                for (int a = 0; a < 3; ++a) o[r][a] += at * vv[a]; } }
        const float* sp = P.st + (size_t)u * (GHV * GHK);
        for (int k = 0; k < GHK; k += 4) { f32x4 sv[3];
#pragma unroll
            for (int a = 0; a < 3; ++a) sv[a] = *(const GAS f32x4*)(sp + (size_t)(lane + 64 * a) * GHK + k);
#pragma unroll
            for (int r = 0; r < 8; ++r) { const float q0 = QD[(wave * 8 + r) * 97 + k], q1 = QD[(wave * 8 + r) * 97 + k + 1], q2 = QD[(wave * 8 + r) * 97 + k + 2], q3 = QD[(wave * 8 + r) * 97 + k + 3];
#pragma unroll
                for (int a = 0; a < 3; ++a) o[r][a] += q0 * sv[a].x + q1 * sv[a].y + q2 * sv[a].z + q3 * sv[a].w; } }
#pragma unroll
        for (int r = 0; r < 8; ++r) {
            const float ss = wave_sum(o[r][0] * o[r][0] + o[r][1] * o[r][1] + o[r][2] * o[r][2]);
            const float rs = 1.f / sqrtf(ss * (1.f / GHV) + LN_EPS);
            const size_t row = (size_t)(t0 + wave * 8 + r);
#pragma unroll
            for (int a = 0; a < 3; ++a) { const int col = h * GHV + lane + 64 * a;
                const float rr = bf2f(P.proj[row * LDP + PC_R + col]);
                const float val = o[r][a] * rs * P.gla_head_g[(size_t)j * GDV + col] * (rr / (1.f + expf(-rr)));
                P.abuf[row * D + col] = (bf16)f2bf(val); }
        }
        __syncthreads();
    }
}

__device__ __forceinline__ void ph_conv_mix(const Ptrs& P, int j, int gtid, int NT) {
    if (SKIPMASK & 128) return;
    const float* w = P.conv_w + (size_t)j * 3 * MIXW;
    for (int idx = gtid; idx < M * (MIXW / 8); idx += NT) {
        const int cg = idx % (MIXW / 8), t = idx / (MIXW / 8), c0 = cg * 8, pos = t % SEQ;
        float y[8];
#pragma unroll
        for (int e = 0; e < 8; ++e) y[e] = 0.f;
#pragma unroll
        for (int k = 0; k < 3; ++k) {
            if (pos - 2 + k < 0) continue;
            const size_t row = (size_t)(t - 2 + k);
            const v4u cc = *(const GAS v4u*)(P.proj + row * LDP + PC_C + c0), hh = *(const GAS v4u*)(P.proj + row * LDP + PC_H + c0);
            const f32x4 w0 = *(const GAS f32x4*)(w + k * MIXW + c0), w1 = *(const GAS f32x4*)(w + k * MIXW + c0 + 4);
            y[0] += w0.x * (bflo(cc.x) * bflo(hh.x)); y[1] += w0.y * (bfhi(cc.x) * bfhi(hh.x)); y[2] += w0.z * (bflo(cc.y) * bflo(hh.y)); y[3] += w0.w * (bfhi(cc.y) * bfhi(hh.y));
            y[4] += w1.x * (bflo(cc.z) * bflo(hh.z)); y[5] += w1.y * (bfhi(cc.z) * bfhi(hh.z)); y[6] += w1.z * (bflo(cc.w) * bflo(hh.w)); y[7] += w1.w * (bfhi(cc.w) * bfhi(hh.w));
        }
        const v4u bb = *(const GAS v4u*)(P.proj + (size_t)t * LDP + PC_B + c0);
        v4u o; o.x = pk2(bflo(bb.x) * y[0], bfhi(bb.x) * y[1]); o.y = pk2(bflo(bb.y) * y[2], bfhi(bb.y) * y[3]); o.z = pk2(bflo(bb.z) * y[4], bfhi(bb.z) * y[5]); o.w = pk2(bflo(bb.w) * y[6], bfhi(bb.w) * y[7]);
        *(GAS v4u*)(P.abuf + (size_t)t * D + c0) = o;
    }
}

__device__ __forceinline__ void ph_xattn(const Ptrs& P, LAS unsigned char* lds, int tid, int bid, int G) {
    if (SKIPMASK & 256) return;
    LAS float* KL = (LAS float*)lds;
    LAS float* VL = (LAS float*)(lds + 256 * 65 * 4);
    LAS float* PL = (LAS float*)(lds + 256 * 65 * 4 + 256 * 64 * 4);
    LAS float* QL = (LAS float*)(lds + 256 * 65 * 4 + 256 * 64 * 4 + 8 * 256 * 4);
    const int lane = tid & 63, wave = tid >> 6;
    for (int u = bid; u < BATCH * XAH * (SEQ / 256); u += G) {
        const int b = u / (XAH * (SEQ / 256)), h = (u / (SEQ / 256)) % XAH, tb = u % (SEQ / 256);
        for (int e = tid; e < NMEM * XAD; e += 512) { const int m = e / XAD, d = e % XAD; const size_t r = (size_t)(b * NMEM + m) * 512;
            KL[m * 65 + d] = bf2f(P.memkv[r + h * XAD + d]); VL[m * 64 + d] = bf2f(P.memkv[r + 256 + h * XAD + d]); }
        __syncthreads();
        for (int tt = 0; tt < 32; ++tt) {
            const size_t t = (size_t)b * SEQ + tb * 256 + wave * 32 + tt;
            QL[wave * 64 + lane] = bf2f(P.proj[t * LDP + PC_MQ + h * XAD + lane]);
            LDS_WAIT(); asm volatile("" ::: "memory");
            float s[4] = {0.f, 0.f, 0.f, 0.f};
            for (int d = 0; d < XAD; ++d) { const float q = QL[wave * 64 + d];
#pragma unroll
                for (int c = 0; c < 4; ++c) s[c] += q * KL[(lane + 64 * c) * 65 + d]; }
#pragma unroll
            for (int c = 0; c < 4; ++c) s[c] *= 0.125f;
            const float mx = wave_max(fmaxf(fmaxf(s[0], s[1]), fmaxf(s[2], s[3])));
            float p[4], ps = 0.f;
#pragma unroll
            for (int c = 0; c < 4; ++c) { p[c] = expf(s[c] - mx); ps += p[c]; PL[wave * 256 + lane + 64 * c] = p[c]; }
            ps = wave_sum(ps);
            LDS_WAIT(); asm volatile("" ::: "memory");
            float o = 0.f;
            for (int m = 0; m < NMEM; ++m) o += PL[wave * 256 + m] * VL[m * 64 + lane];
            P.abuf[t * D + MIXW + h * XAD + lane] = (bf16)f2bf(o / ps);
            LDS_WAIT(); asm volatile("" ::: "memory");
        }
        __syncthreads();
    }
}


typedef short bf16x8v __attribute__((ext_vector_type(8)));
__device__ __forceinline__ unsigned cvtpk(float lo, float hi) { unsigned r; asm volatile("v_cvt_pk_bf16_f32 %0, %1, %2" : "=v"(r) : "v"(lo), "v"(hi)); return r; }
__device__ __forceinline__ void ph_xattn_mfma(const Ptrs& P, LAS unsigned char* lds, int tid, int bid, int G) {
    constexpr int KST = 144, VST = 528;
    LAS unsigned char* KL = lds;
    LAS unsigned char* VL = lds + 256 * KST;
    const int lane = tid & 63, wave = tid >> 6, fr = lane & 15, fq = lane >> 4;
    for (int u = bid; u < BATCH * XAH * (SEQ / 256); u += G) {
        const int b = u / (XAH * (SEQ / 256)), h = (u / (SEQ / 256)) % XAH, tb = u % (SEQ / 256);
        for (int e = tid; e < NMEM * 8; e += 512) { const int m = e >> 3, c = e & 7; const bf16* src = P.memkv + (size_t)(b * NMEM + m) * 512 + h * XAD + c * 8;
            const v4u kv = *(const GAS v4u*)src, vv = *(const GAS v4u*)(src + 256);
            *(LAS v4u*)(KL + m * KST + c * 16) = kv;
            const int slot = (m & ~31) + 8 * ((m >> 2) & 3) + 4 * ((m >> 4) & 1) + (m & 3);
            LAS unsigned short* vd = (LAS unsigned short*)(VL + (c * 8) * VST + slot * 2);
            vd[0 * (VST / 2)] = (unsigned short)(vv.x & 0xffffu); vd[1 * (VST / 2)] = (unsigned short)(vv.x >> 16); vd[2 * (VST / 2)] = (unsigned short)(vv.y & 0xffffu); vd[3 * (VST / 2)] = (unsigned short)(vv.y >> 16);
            vd[4 * (VST / 2)] = (unsigned short)(vv.z & 0xffffu); vd[5 * (VST / 2)] = (unsigned short)(vv.z >> 16); vd[6 * (VST / 2)] = (unsigned short)(vv.w & 0xffffu); vd[7 * (VST / 2)] = (unsigned short)(vv.w >> 16); }
        __syncthreads();
#pragma unroll 1
        for (int pass = 0; pass < 2; ++pass) {
            const size_t t = (size_t)b * SEQ + tb * 256 + wave * 32 + pass * 16 + fr;
            bf16x8v qf[2];
#pragma unroll
            for (int ks = 0; ks < 2; ++ks) qf[ks] = *(const GAS bf16x8v*)(P.proj + t * LDP + PC_MQ + h * XAD + 32 * ks + 8 * fq);
            f32x4 s[16];
#pragma unroll
            for (int tl = 0; tl < 16; ++tl) { s[tl] = (f32x4){0.f, 0.f, 0.f, 0.f};
#pragma unroll
                for (int ks = 0; ks < 2; ++ks) { const bf16x8v a = *(const LAS bf16x8v*)(KL + (16 * tl + fr) * KST + (32 * ks + 8 * fq) * 2); s[tl] = __builtin_amdgcn_mfma_f32_16x16x32_bf16(a, qf[ks], s[tl], 0, 0, 0); } }
            float mx = -3.0e38f;
#pragma unroll
            for (int tl = 0; tl < 16; ++tl) mx = fmaxf(mx, fmaxf(fmaxf(s[tl][0], s[tl][1]), fmaxf(s[tl][2], s[tl][3])));
            mx = fmaxf(mx, __shfl_xor(mx, 16)); mx = fmaxf(mx, __shfl_xor(mx, 32));
            float ps = 0.f;
#pragma unroll
            for (int tl = 0; tl < 16; ++tl)
#pragma unroll
                for (int r = 0; r < 4; ++r) { const float pv = exp2f((s[tl][r] - mx) * 0.18033688011112042f); s[tl][r] = pv; ps += pv; }
            ps += __shfl_xor(ps, 16); ps += __shfl_xor(ps, 32);
            f32x4 o[4];
#pragma unroll
            for (int dt = 0; dt < 4; ++dt) o[dt] = (f32x4){0.f, 0.f, 0.f, 0.f};
#pragma unroll
            for (int ks = 0; ks < 8; ++ks) {
                v4u pw; pw.x = cvtpk(s[2 * ks][0], s[2 * ks][1]); pw.y = cvtpk(s[2 * ks][2], s[2 * ks][3]); pw.z = cvtpk(s[2 * ks + 1][0], s[2 * ks + 1][1]); pw.w = cvtpk(s[2 * ks + 1][2], s[2 * ks + 1][3]);
                const bf16x8v pf = __builtin_bit_cast(bf16x8v, pw);
#pragma unroll
                for (int dt = 0; dt < 4; ++dt) { const bf16x8v a = *(const LAS bf16x8v*)(VL + (16 * dt + fr) * VST + (32 * ks + 8 * fq) * 2); o[dt] = __builtin_amdgcn_mfma_f32_16x16x32_bf16(a, pf, o[dt], 0, 0, 0); }
            }
            const float inv = 1.f / ps;
#pragma unroll
            for (int dt = 0; dt < 4; ++dt) { v2u w; w.x = cvtpk(o[dt][0] * inv, o[dt][1] * inv); w.y = cvtpk(o[dt][2] * inv, o[dt][3] * inv);
                *(GAS v2u*)(P.abuf + t * D + MIXW + h * XAD + 16 * dt + 4 * fq) = w; }
        }
        __syncthreads();
    }
}


__device__ __forceinline__ void ph_gla_a(const Ptrs& P, int j, LAS unsigned char* lds, int tid, int bid, int G) {
    if (SKIPMASK & 2048) return;
    constexpr int RS = 144;
    LAS unsigned char* VT = lds;
    LAS unsigned char* KT = lds + 384 * RS;
    LAS float* GL = (LAS float*)(lds + 2 * 384 * RS);
    LAS float* DL = (LAS float*)(lds + 2 * 384 * RS + 4096);
    const int lane = tid & 63, wave = tid >> 6, fr = lane & 15, fq = lane >> 4;
    const float scale = 0.10206207261596577f;
    for (int u = bid; u < BATCH * NCH; u += G) {
        const size_t t0 = (size_t)u * CH; const int b = u >> 5, n = u & 31;
        for (int e = tid; e < CH * RANK; e += 512) GL[e] = bf2f(P.proj[(t0 + (e >> 4)) * LDP + PC_GATE + (e & 15)]);
        __syncthreads();
        if (tid < GDK) {
            const int c = tid;
            float w[RANK];
#pragma unroll
            for (int r = 0; r < RANK; ++r) w[r] = P.gla_w_a2[((size_t)j * RANK + r) * GDK + c];
            const float bias = P.gla_b_a[(size_t)j * GDK + c];
            const bf16* qp = P.proj + t0 * LDP + PC_Q + c; const bf16* kp = P.proj + t0 * LDP + PC_K + c;
            bf16* qd = P.qd + t0 * GDK + c; bf16* ki = P.ki + t0 * GDK + c;
            float Gc = 0.f; unsigned prevb = 0u;
#pragma unroll 1
            for (int tb = 0; tb < CH; tb += 8) {
                float qv[8], kv[8];
#pragma unroll
                for (int e = 0; e < 8; ++e) { qv[e] = bf2f(qp[(size_t)(tb + e) * LDP]); kv[e] = bf2f(kp[(size_t)(tb + e) * LDP]); }
#pragma unroll
                for (int e = 0; e < 8; ++e) { const int t = tb + e;
                    const f32x4 g0 = *(const LAS f32x4*)(GL + t * 16), g1 = *(const LAS f32x4*)(GL + t * 16 + 4), g2 = *(const LAS f32x4*)(GL + t * 16 + 8), g3 = *(const LAS f32x4*)(GL + t * 16 + 12);
                    float z = bias;
                    z += g0.x * w[0] + g0.y * w[1] + g0.z * w[2] + g0.w * w[3] + g1.x * w[4] + g1.y * w[5] + g1.z * w[6] + g1.w * w[7];
                    z += g2.x * w[8] + g2.y * w[9] + g2.z * w[10] + g2.w * w[11] + g3.x * w[12] + g3.y * w[13] + g3.z * w[14] + g3.w * w[15];
                    const float ls = fminf(z, 0.f) - __logf(1.f + __expf(-fabsf(z)));
                    Gc += ls * (1.0f / 16.0f);
                    const float eg = __expf(Gc), ieg = __expf(-Gc);
                    qd[(size_t)t * GDK] = (bf16)f2bf(qv[e] * scale * eg);
                    const unsigned kb = f2bf(kv[e] * ieg);
                    ki[(size_t)t * GDK] = (bf16)kb;
                    if (e & 1) *(LAS unsigned*)(KT + c * RS + (t >> 1) * 4) = prevb | (kb << 16); else prevb = kb; }
            }
            const float dc = __expf(Gc);
            DL[c] = dc; P.dec[(size_t)u * GDK + c] = dc;
        }
#pragma unroll 1
        for (int hp = 0; hp < 2; ++hp) {
            for (int e = tid; e < CH * 48; e += 512) { const int t = e / 48, c8 = e % 48;
                const v4u vv = *(const GAS v4u*)(P.proj + (t0 + t) * LDP + PC_V + hp * 384 + c8 * 8);
                LAS unsigned short* vd = (LAS unsigned short*)(VT + (c8 * 8) * RS + t * 2);
                vd[0 * (RS / 2)] = (unsigned short)(vv.x & 0xffffu); vd[1 * (RS / 2)] = (unsigned short)(vv.x >> 16); vd[2 * (RS / 2)] = (unsigned short)(vv.y & 0xffffu); vd[3 * (RS / 2)] = (unsigned short)(vv.y >> 16);
                vd[4 * (RS / 2)] = (unsigned short)(vv.z & 0xffffu); vd[5 * (RS / 2)] = (unsigned short)(vv.z >> 16); vd[6 * (RS / 2)] = (unsigned short)(vv.w & 0xffffu); vd[7 * (RS / 2)] = (unsigned short)(vv.w >> 16); }
            __syncthreads();
            const int hl = wave >> 2, head = 2 * hp + hl, vt0 = 3 * (wave & 3);
            f32x4 acc[3][6];
#pragma unroll
            for (int a = 0; a < 3; ++a)
#pragma unroll
                for (int it = 0; it < 6; ++it) acc[a][it] = (f32x4){0.f, 0.f, 0.f, 0.f};
#pragma unroll
            for (int ks = 0; ks < 2; ++ks) {
                bf16x8v bfr[3];
#pragma unroll
                for (int a = 0; a < 3; ++a) bfr[a] = *(const LAS bf16x8v*)(VT + (hl * 192 + 16 * (vt0 + a) + fr) * RS + (32 * ks + 8 * fq) * 2);
#pragma unroll
                for (int it = 0; it < 6; ++it) { const bf16x8v afr = *(const LAS bf16x8v*)(KT + (head * 96 + 16 * it + fr) * RS + (32 * ks + 8 * fq) * 2);
#pragma unroll
                    for (int a = 0; a < 3; ++a) acc[a][it] = __builtin_amdgcn_mfma_f32_16x16x32_bf16(afr, bfr[a], acc[a][it], 0, 0, 0); }
            }
            bf16* so = P.stb + (size_t)((b * GH + head) * NCH + n) * (GHV * GHK);
#pragma unroll
            for (int it = 0; it < 6; ++it) { const f32x4 d = *(const LAS f32x4*)(DL + head * 96 + 16 * it + 4 * fq);
#pragma unroll
                for (int a = 0; a < 3; ++a) { const f32x4 x = acc[a][it] * d; v2u w2; w2.x = cvtpk(x[0], x[1]); w2.y = cvtpk(x[2], x[3]);
                    *(GAS v2u*)(so + (size_t)(16 * (vt0 + a) + fr) * GHK + 16 * it + 4 * fq) = w2; } }
            __syncthreads();
        }
    }
}

__device__ __forceinline__ void ph_gla_scan2(const Ptrs& P, int gtid, int NT) {
    if (SKIPMASK & 4096) return;
    constexpr int E8 = GHV * GHK / 8;
    for (int idx = gtid; idx < BATCH * GH * E8; idx += NT) {
        const int e8 = idx % E8, bh = idx / E8, b = bh >> 2, h = bh & 3, i0 = (e8 % (GHK / 8)) * 8;
        float S[8];
#pragma unroll
        for (int e = 0; e < 8; ++e) S[e] = 0.f;
        GAS v4u* sp = (GAS v4u*)(P.stb + (size_t)bh * NCH * (GHV * GHK) + (size_t)e8 * 8);
        const float* dp = P.dec + (size_t)b * NCH * GDK + h * GHK + i0;
#pragma unroll 1
        for (int n0 = 0; n0 < NCH; n0 += 4) {
            v4u kv[4]; f32x4 d0[4], d1[4];
#pragma unroll
            for (int q = 0; q < 4; ++q) { kv[q] = sp[(size_t)(n0 + q) * (GHV * GHK / 8)]; d0[q] = *(const GAS f32x4*)(dp + (size_t)(n0 + q) * GDK); d1[q] = *(const GAS f32x4*)(dp + (size_t)(n0 + q) * GDK + 4); }
#pragma unroll
            for (int q = 0; q < 4; ++q) {
                v4u o; o.x = cvtpk(S[0], S[1]); o.y = cvtpk(S[2], S[3]); o.z = cvtpk(S[4], S[5]); o.w = cvtpk(S[6], S[7]);
                sp[(size_t)(n0 + q) * (GHV * GHK / 8)] = o;
                S[0] = d0[q].x * S[0] + bflo(kv[q].x); S[1] = d0[q].y * S[1] + bfhi(kv[q].x); S[2] = d0[q].z * S[2] + bflo(kv[q].y); S[3] = d0[q].w * S[3] + bfhi(kv[q].y);
                S[4] = d1[q].x * S[4] + bflo(kv[q].z); S[5] = d1[q].y * S[5] + bfhi(kv[q].z); S[6] = d1[q].z * S[6] + bflo(kv[q].w); S[7] = d1[q].w * S[7] + bfhi(kv[q].w);
            }
        }
    }
}

__device__ __forceinline__ void ph_gla_c(const Ptrs& P, int j, LAS unsigned char* lds, int tid, int bid, int G) {
    if (SKIPMASK & 8192) return;
    constexpr int RS = 144;
    LAS unsigned char* VT = lds;
    const int lane = tid & 63, wave = tid >> 6, fr = lane & 15, fq = lane >> 4;
    for (int u = bid; u < BATCH * NCH; u += G) {
        const size_t t0 = (size_t)u * CH; const int b = u >> 5, n = u & 31;
#pragma unroll 1
        for (int hp = 0; hp < 2; ++hp) {
            for (int e = tid; e < CH * 48; e += 512) { const int t = e / 48, c8 = e % 48;
                const v4u vv = *(const GAS v4u*)(P.proj + (t0 + t) * LDP + PC_V + hp * 384 + c8 * 8);
                const int slot = (t & ~31) + 8 * ((t >> 2) & 3) + 4 * ((t >> 4) & 1) + (t & 3);
                LAS unsigned short* vd = (LAS unsigned short*)(VT + (c8 * 8) * RS + slot * 2);
                vd[0 * (RS / 2)] = (unsigned short)(vv.x & 0xffffu); vd[1 * (RS / 2)] = (unsigned short)(vv.x >> 16); vd[2 * (RS / 2)] = (unsigned short)(vv.y & 0xffffu); vd[3 * (RS / 2)] = (unsigned short)(vv.y >> 16);
                vd[4 * (RS / 2)] = (unsigned short)(vv.z & 0xffffu); vd[5 * (RS / 2)] = (unsigned short)(vv.z >> 16); vd[6 * (RS / 2)] = (unsigned short)(vv.w & 0xffffu); vd[7 * (RS / 2)] = (unsigned short)(vv.w >> 16); }
            __syncthreads();
            const int hl = wave >> 2, head = 2 * hp + hl, it = wave & 3;
            const size_t ti = t0 + 16 * it + fr;
            bf16x8v qf[3];
#pragma unroll
            for (int ks = 0; ks < 3; ++ks) qf[ks] = *(const GAS bf16x8v*)(P.qd + ti * GDK + head * GHK + 32 * ks + 8 * fq);
            f32x4 at[4];
#pragma unroll
            for (int jt = 0; jt < 4; ++jt) { at[jt] = (f32x4){0.f, 0.f, 0.f, 0.f};
                if (jt <= it) {
#pragma unroll
                    for (int ks = 0; ks < 3; ++ks) { const bf16x8v a = *(const GAS bf16x8v*)(P.ki + (t0 + 16 * jt + fr) * GDK + head * GHK + 32 * ks + 8 * fq); at[jt] = __builtin_amdgcn_mfma_f32_16x16x32_bf16(a, qf[ks], at[jt], 0, 0, 0); }
                    if (jt == it) {
#pragma unroll
                        for (int r = 0; r < 4; ++r) at[jt][r] = (4 * fq + r <= fr) ? at[jt][r] : 0.f; }
                } }
            bf16x8v pf[2];
#pragma unroll
            for (int k2 = 0; k2 < 2; ++k2) { v4u pw; pw.x = cvtpk(at[2 * k2][0], at[2 * k2][1]); pw.y = cvtpk(at[2 * k2][2], at[2 * k2][3]); pw.z = cvtpk(at[2 * k2 + 1][0], at[2 * k2 + 1][1]); pw.w = cvtpk(at[2 * k2 + 1][2], at[2 * k2 + 1][3]);
                pf[k2] = __builtin_bit_cast(bf16x8v, pw); }
            const bf16* sp = P.stb + (size_t)((b * GH + head) * NCH + n) * (GHV * GHK);
            f32x4 o[12]; float ss = 0.f;
#pragma unroll
            for (int vt = 0; vt < 12; ++vt) { o[vt] = (f32x4){0.f, 0.f, 0.f, 0.f};
#pragma unroll
                for (int k2 = 0; k2 < 2; ++k2) { const bf16x8v a = *(const LAS bf16x8v*)(VT + (hl * 192 + 16 * vt + fr) * RS + (32 * k2 + 8 * fq) * 2); o[vt] = __builtin_amdgcn_mfma_f32_16x16x32_bf16(a, pf[k2], o[vt], 0, 0, 0); }
#pragma unroll
                for (int ks = 0; ks < 3; ++ks) { const bf16x8v a = *(const GAS bf16x8v*)(sp + (size_t)(16 * vt + fr) * GHK + 32 * ks + 8 * fq); o[vt] = __builtin_amdgcn_mfma_f32_16x16x32_bf16(a, qf[ks], o[vt], 0, 0, 0); }
                ss += (o[vt][0] * o[vt][0] + o[vt][1] * o[vt][1]) + (o[vt][2] * o[vt][2] + o[vt][3] * o[vt][3]); }
            ss += __shfl_xor(ss, 16); ss += __shfl_xor(ss, 32);
            const float rs = 1.f / sqrtf(ss * (1.f / GHV) + LN_EPS);
#pragma unroll
            for (int vt = 0; vt < 12; ++vt) { const int col = head * GHV + 16 * vt + 4 * fq;
                const v2u rr = *(const GAS v2u*)(P.proj + ti * LDP + PC_R + col); const f32x4 hg = *(const GAS f32x4*)(P.gla_head_g + (size_t)j * GDV + col);
                const float r0 = bflo(rr.x), r1 = bfhi(rr.x), r2 = bflo(rr.y), r3 = bfhi(rr.y);
                const float y0 = o[vt][0] * rs * hg.x * (r0 / (1.f + __expf(-r0))), y1 = o[vt][1] * rs * hg.y * (r1 / (1.f + __expf(-r1)));
                const float y2 = o[vt][2] * rs * hg.z * (r2 / (1.f + __expf(-r2))), y3 = o[vt][3] * rs * hg.w * (r3 / (1.f + __expf(-r3)));
                v2u w2; w2.x = cvtpk(y0, y1); w2.y = cvtpk(y2, y3);
                *(GAS v2u*)(P.abuf + ti * D + col) = w2; }
            __syncthreads();
        }
    }
}

__device__ __forceinline__ void ph_convgate(const Ptrs& P, int l, int gtid, int NT) {
    if (SKIPMASK & 512) return;
    const float* w = P.ffn_conv_w + (size_t)l * 3 * DFF2; const float* bs = P.ffn_conv_b + (size_t)l * DFF2;
    for (int idx = gtid; idx < M * (DFF / 8); idx += NT) {
        const int cg = idx % (DFF / 8), t = idx / (DFF / 8), c0 = cg * 8, pos = t % SEQ;
        float yg[8], yv[8];
        { const f32x4 a0 = *(const GAS f32x4*)(bs + c0), a1 = *(const GAS f32x4*)(bs + c0 + 4), b0 = *(const GAS f32x4*)(bs + DFF + c0), b1 = *(const GAS f32x4*)(bs + DFF + c0 + 4);
          yg[0] = a0.x; yg[1] = a0.y; yg[2] = a0.z; yg[3] = a0.w; yg[4] = a1.x; yg[5] = a1.y; yg[6] = a1.z; yg[7] = a1.w;
          yv[0] = b0.x; yv[1] = b0.y; yv[2] = b0.z; yv[3] = b0.w; yv[4] = b1.x; yv[5] = b1.y; yv[6] = b1.z; yv[7] = b1.w; }
#pragma unroll
        for (int k = 0; k < 3; ++k) {
            if (pos - 2 + k < 0) continue;
            const size_t row = (size_t)(t - 2 + k);
            const v4u ug = *(const GAS v4u*)(P.u + row * DFF2 + c0), uv = *(const GAS v4u*)(P.u + row * DFF2 + DFF + c0);
            const f32x4 g0 = *(const GAS f32x4*)(w + k * DFF2 + c0), g1 = *(const GAS f32x4*)(w + k * DFF2 + c0 + 4), v0 = *(const GAS f32x4*)(w + k * DFF2 + DFF + c0), v1 = *(const GAS f32x4*)(w + k * DFF2 + DFF + c0 + 4);
            yg[0] += g0.x * bflo(ug.x); yg[1] += g0.y * bfhi(ug.x); yg[2] += g0.z * bflo(ug.y); yg[3] += g0.w * bfhi(ug.y); yg[4] += g1.x * bflo(ug.z); yg[5] += g1.y * bfhi(ug.z); yg[6] += g1.z * bflo(ug.w); yg[7] += g1.w * bfhi(ug.w);
            yv[0] += v0.x * bflo(uv.x); yv[1] += v0.y * bfhi(uv.x); yv[2] += v0.z * bflo(uv.y); yv[3] += v0.w * bfhi(uv.y); yv[4] += v1.x * bflo(uv.z); yv[5] += v1.y * bfhi(uv.z); yv[6] += v1.z * bflo(uv.w); yv[7] += v1.w * bfhi(uv.w);
        }
        float hv[8];
#pragma unroll
        for (int e = 0; e < 8; ++e) hv[e] = (yg[e] / (1.f + expf(-yg[e]))) * yv[e];
        v4u o; o.x = pk2(hv[0], hv[1]); o.y = pk2(hv[2], hv[3]); o.z = pk2(hv[4], hv[5]); o.w = pk2(hv[6], hv[7]);
        *(GAS v4u*)(P.h + (size_t)t * DFF + c0) = o;
    }
}

constexpr int N_PHASES = 1 + 2 * (GLA_MFMA ? 10 : 11) + 2 * 8 - (FFN_FUSED ? 4 : 0);
struct Args { const float* in[19]; float* out; unsigned char* ws; int ph_lo, ph_hi, li, pad; };
__global__ void __launch_bounds__(NWAVES * 64, 2) trunk_fwd(Args args) {
    extern __shared__ __attribute__((aligned(16))) unsigned char lds_raw[];
    LAS unsigned char* lds = (LAS unsigned char*)lds_raw;
    volatile LAS unsigned* MISC = (volatile LAS unsigned*)(lds + MISC_OFF);
    const int G = gridDim.x, NT = G * NWAVES * 64, NGW = G * NWAVES;
    unsigned char* ws = args.ws;
    LAS unsigned long long* PT = (LAS unsigned long long*)(lds + PTAB_OFF);
    if (threadIdx.x == 0) {
        PT[0] = (unsigned long long)args.in[0]; PT[1] = (unsigned long long)args.in[1]; PT[2] = (unsigned long long)args.in[2]; PT[3] = (unsigned long long)args.in[3]; PT[4] = (unsigned long long)args.in[4];
        PT[5] = (unsigned long long)args.in[5]; PT[6] = (unsigned long long)args.in[6]; PT[7] = (unsigned long long)args.in[7]; PT[8] = (unsigned long long)args.in[8]; PT[9] = (unsigned long long)args.in[9];
        PT[10] = (unsigned long long)args.in[10]; PT[11] = (unsigned long long)args.in[11]; PT[12] = (unsigned long long)args.in[12]; PT[13] = (unsigned long long)args.in[13]; PT[14] = (unsigned long long)args.in[14];
        PT[15] = (unsigned long long)args.in[15]; PT[16] = (unsigned long long)args.in[16]; PT[17] = (unsigned long long)args.in[17]; PT[18] = (unsigned long long)args.in[18]; PT[19] = (unsigned long long)args.out;
    }
    if (threadIdx.x < 64) MISC[threadIdx.x] = 0u;
    __syncthreads();
    XcdBarrier bar; bar.bar = (unsigned*)(ws + WS_CTL) + CW_BAR; bar.x = 0; bar.st = nullptr;
#if ONE_LAUNCH
    bar = xcd_barrier_post((unsigned*)(ws + WS_CTL) + CW_BAR, MISC + 8);
#endif
    const int lo = args.ph_lo, hi = args.ph_hi;
    int p = 0;
#if ONE_LAUNCH
#define GRID_BAR() xcd_barrier(bar)
#else
#define GRID_BAR() do {} while (0)
#endif
#define RUN(...) do { if (p >= lo && p < hi) { int tid = threadIdx.x; asm volatile("" : "+v"(tid)); int bid = blockIdx.x; asm volatile("" : "+s"(bid)); \
        const int lane = tid & 63, wave = __builtin_amdgcn_readfirstlane(tid >> 6), gtid = bid * (NWAVES * 64) + tid, gw = bid * NWAVES + wave; (void)lane; (void)gtid; (void)gw; \
        Ptrs P; load_ptrs(P, PT, ws); __VA_ARGS__; if (p + 1 < hi) GRID_BAR(); } ++p; } while (0)

    RUN(ph_prologue(P, gtid, NT); ph_convert(P, 0, lds, gw, NGW, lane, gtid, NT));
    for (int l = 0; l < DEPTH; ++l) {
        const bool gla = (l & 1) == 0; const int j = l >> 1;
        RUN({ pg8::Gemm g{P.xn, P.win, M, gla ? LDP : CONV_IN, D}; pg8::StaticOrder S; S.init(M, gla ? LDP : CONV_IN, G, bid);
              pg8::EpiBf16 E{P.proj, LDP};
              if (!(SKIPMASK & 1024)) pg8::gemm_phase<pg8::EpiBf16, pg8::StaticOrder, true, true>(lds + RING_OFF, g, S, E, tid);
              pg8::Gemm g2{P.memb, P.wmkv, MM, 512, D}; pg8::StaticOrder S2; S2.init(MM, 512, G, bid);
              pg8::EpiBf16 E2{P.memkv, 512};
              if (!(SKIPMASK & 1024)) pg8::gemm_phase<pg8::EpiBf16, pg8::StaticOrder, true, true>(lds + RING_OFF, g2, S2, E2, tid); });
        RUN({ if (gla) { if (GLA_MFMA) { REP(8) ph_gla_a(P, j, lds, tid, bid, G); } else { REP(8) ph_gla_g(P, j, gtid, NT); } } else { REP(128) ph_conv_mix(P, j, gtid, NT); }
              REP(256) { if (XATTN_MFMA) ph_xattn_mfma(P, lds, tid, bid, G); else ph_xattn(P, lds, tid, bid, G); } });
        if (gla) {
            if (!GLA_MFMA) RUN(REP(16) ph_gla_kv(P, lds, tid, bid, G));
            RUN({ if (GLA_MFMA) ph_gla_scan2(P, gtid, NT); else ph_gla_scan(P, gtid, NT); });
            RUN({ if (GLA_MFMA) { REP(64) ph_gla_c(P, j, lds, tid, bid, G); } else { REP(64) ph_gla_out(P, j, lds, tid, bid, G); } });
        }
        RUN({ pg8::Gemm g{P.abuf, P.wout, M, D, D}; pg8::StaticOrder S; S.init(M, D, G, bid);
              pg8::EpiResid E{P.xres, D, DN_ALPHA};
              if (!(SKIPMASK & 1024)) pg8::gemm_phase<pg8::EpiResid, pg8::StaticOrder, true, true>(lds + RING_OFF, g, S, E, tid); });
        RUN(ph_ln(P, P.ln1_g + (size_t)l * D, P.ln1_b + (size_t)l * D, gw, NGW, lane));
        if (FFN_FUSED) {
            RUN({ pg8::Gemm g{P.xn - 2 * D, P.wup, M, DFF2, D}; pg8::StaticOrder S; S.init_tiles(66, DFF2 / 256, G, bid);
                  pg8::EpiConvGate E{P.h, P.ffn_conv_w + (size_t)l * 3 * DFF2, P.ffn_conv_b + (size_t)l * DFF2, M};
                  pg8::gemm_phase<pg8::EpiConvGate, pg8::StaticOrder, true, true, 1>(lds + RING_OFF, g, S, E, tid); });
        } else {
            RUN({ pg8::Gemm g{P.xn, P.wup, M, DFF2, D}; pg8::StaticOrder S; S.init(M, DFF2, G, bid);
                  pg8::EpiBf16 E{P.u, DFF2};
                  pg8::gemm_phase<pg8::EpiBf16, pg8::StaticOrder, true, true>(lds + RING_OFF, g, S, E, tid); });
            RUN(REP(512) ph_convgate(P, l, gtid, NT));
        }
        RUN({ pg8::Gemm g{P.h, P.wdn, M, D, DFF}; pg8::StaticOrder S; S.init(M, D, G, bid);
              pg8::EpiResid E{P.xres, D, DN_ALPHA};
              if (!(SKIPMASK & 1024)) pg8::gemm_phase<pg8::EpiResid, pg8::StaticOrder, true, true>(lds + RING_OFF, g, S, E, tid); });
        RUN({ ph_ln(P, P.ln2_g + (size_t)l * D, P.ln2_b + (size_t)l * D, gw, NGW, lane);
              if (l + 1 < DEPTH) { REP(2) ph_convert(P, l + 1, lds, gw, NGW, lane, gtid, NT); } });
    }
#undef RUN
}

extern "C" void kernel_launch(void* const* d_in, const int* in_sizes, int n_in, void* d_out, int out_size, void* d_ws, size_t ws_size, hipStream_t stream) {
    static int grid = 0;
    if (grid == 0) {
        if (n_in != 19 || out_size != M * D || ws_size < WS_END) { fprintf(stderr, "kernel_launch: unexpected shapes: n_in %d out %d ws %zu\n", n_in, out_size, ws_size); grid = -1; return; }
        int dev = 0, cus = 0, per_cu = 0;
        if (hipGetDevice(&dev) != hipSuccess || hipDeviceGetAttribute(&cus, hipDeviceAttributeMultiprocessorCount, dev) != hipSuccess) { grid = -1; return; }
        if (hipFuncSetAttribute((const void*)trunk_fwd, hipFuncAttributeMaxDynamicSharedMemorySize, LDS_BYTES) != hipSuccess) { fprintf(stderr, "kernel_launch: hipFuncSetAttribute failed\n"); grid = -1; return; }
        if (hipOccupancyMaxActiveBlocksPerMultiprocessor(&per_cu, (const void*)trunk_fwd, NWAVES * 64, LDS_BYTES) != hipSuccess || per_cu < 1) { fprintf(stderr, "kernel_launch: occupancy query says %d\n", per_cu); }
        (void)hipGetLastError();
        grid = cus;
    }
    if (grid < 0) return;
    if (hipMemsetAsync((char*)d_ws + WS_CTL, 0, CTL_ZERO_BYTES, stream) != hipSuccess) return;
    Args a{};
    for (int i = 0; i < 19; ++i) a.in[i] = (const float*)d_in[i];
    a.out = (float*)d_out; a.ws = (unsigned char*)d_ws;
#if ONE_LAUNCH
    a.ph_lo = 0; a.ph_hi = N_PHASES; a.li = 0;
    hipLaunchKernelGGL(trunk_fwd, dim3(grid), dim3(NWAVES * 64), LDS_BYTES, stream, a);
#else
    for (int p = 0; p < N_PHASES; ++p) { a.ph_lo = p; a.ph_hi = p + 1; a.li = p; hipLaunchKernelGGL(trunk_fwd, dim3(grid), dim3(NWAVES * 64), LDS_BYTES, stream, a); }
#endif
}
```
